# Optimizing an MI355X kernel written in HIP

```python
import math
import jax, jax.numpy as jnp
from jax import lax
import numpy as np

D_MODEL = 1024
BATCH = 2
SEQ = 16384
DEPTH = 4

N_MIXERS = 2
N_SUB = 3
D_FF = 2816
D_RNN = D_MODEL
RG_HEADS = 8
RG_HEAD_DIM = D_RNN // RG_HEADS
CONV_W = 4
RG_C = 8.0
D_G = 2 * D_MODEL
GM_GROUPS = 8
GM_GROUP_DIM = D_G // GM_GROUPS
CHUNK = 128
N_RG = (DEPTH + 1) // 2
N_GM = DEPTH // 2
EPS = 1e-6

kernel_name = "hybrid_rglru_gmlp_macaron_trunk"


def rmsnorm(x, g):
    xf = x.astype(jnp.float32)
    y = xf * lax.rsqrt(jnp.mean(xf * xf, axis=-1, keepdims=True) + EPS)
    return (y * g.astype(jnp.float32)).astype(x.dtype)


def layernorm(x, g, b):
    xf = x.astype(jnp.float32)
    mu = jnp.mean(xf, axis=-1, keepdims=True)
    var = jnp.mean(jnp.square(xf - mu), axis=-1, keepdims=True)
    y = (xf - mu) * lax.rsqrt(var + EPS)
    return (y * g.astype(jnp.float32) + b.astype(jnp.float32)).astype(x.dtype)


def swiglu(h, w_in, w_out):
    gate, up = jnp.split(h @ w_in, 2, axis=-1)
    return (jax.nn.silu(gate) * up) @ w_out


def causal_depthwise_conv(x, w, b):
    S = x.shape[1]
    xp = jnp.pad(x, ((0, 0), (CONV_W - 1, 0), (0, 0)))
    y = b
    for k in range(CONV_W):
        y = y + xp[:, k:k + S, :] * w[k]
    return y


def _lin_combine(left, right):
    a1, b1 = left
    a2, b2 = right
    return a1 * a2, a2 * b1 + b2


def rglru_mixer(h, w_in, conv_w, conv_b, w_a, b_a, w_x, b_x, lam, w_out):
    B, S, _ = h.shape
    xb, gb = jnp.split(h @ w_in, 2, axis=-1)
    xb = causal_depthwise_conv(xb, conv_w, conv_b)
    xh = xb.reshape(B, S, RG_HEADS, RG_HEAD_DIM)
    r = jax.nn.sigmoid(jnp.einsum('bshd,hde->bshe', xh, w_a).reshape(B, S, D_RNN) + b_a)
    i = jax.nn.sigmoid(jnp.einsum('bshd,hde->bshe', xh, w_x).reshape(B, S, D_RNN) + b_x)
    log_a = -RG_C * r.astype(jnp.float32) * jax.nn.softplus(-lam.astype(jnp.float32))
    a = jnp.exp(log_a)
    mult = jnp.sqrt(-jnp.expm1(2.0 * log_a))
    bt = mult * (i * xb).astype(jnp.float32)
    _, hs = lax.associative_scan(_lin_combine, (a, bt), axis=1)
    y = hs.astype(h.dtype) * jax.nn.gelu(gb)
    return y @ w_out


def gmlp_mixer(h, w_in, ln_g, ln_b, w_s, b_s, w_out):
    B, S, _ = h.shape
    u, v = jnp.split(jax.nn.gelu(h @ w_in), 2, axis=-1)
    v = layernorm(v, ln_g, ln_b)
    vc = v.reshape(B, S // CHUNK, CHUNK, GM_GROUPS, GM_GROUP_DIM)
    mask = jnp.tril(jnp.ones((CHUNK, CHUNK), dtype=w_s.dtype))
    ws = w_s * mask
    vm = jnp.einsum('gts,bcsgd->bctgd', ws, vc) + b_s.T[None, None, :, :, None]
    y = u * vm.reshape(B, S, D_G)
    return y @ w_out


def setup_inputs(seed: int = 0) -> dict:
    key = jax.random.key(seed)
    ks = jax.random.split(key, 32)
    nrm = lambda k, shape, s: jax.random.normal(k, shape, jnp.float32) * s
    D = D_MODEL
    u_lam = jax.random.uniform(ks[20], (N_RG, D_RNN), jnp.float32, 0.9, 0.999)
    return {
        "x": nrm(ks[0], (BATCH, SEQ, D), 1.0),
        "c": nrm(ks[1], (BATCH, D), 1.0),
        "ada_w": nrm(ks[2], (DEPTH, D, N_SUB * 3 * D), 0.5 * D ** -0.5),
        "ada_b": nrm(ks[3], (DEPTH, N_SUB * 3 * D), 0.01),
        "norm_pre": 1.0 + nrm(ks[4], (DEPTH, N_SUB, D), 0.05),
        "norm_post": 1.0 + nrm(ks[5], (DEPTH, N_SUB, D), 0.05),
        "ffn_w_in": nrm(ks[6], (DEPTH, 2, D, 2 * D_FF), D ** -0.5),
        "ffn_w_out": nrm(ks[7], (DEPTH, 2, D_FF, D), D_FF ** -0.5),
        "rg_w_in": nrm(ks[8], (N_RG, D, 2 * D_RNN), D ** -0.5),
        "rg_conv_w": nrm(ks[9], (N_RG, CONV_W, D_RNN), CONV_W ** -0.5),
        "rg_conv_b": nrm(ks[10], (N_RG, D_RNN), 0.01),
        "rg_w_a": nrm(ks[11], (N_RG, RG_HEADS, RG_HEAD_DIM, RG_HEAD_DIM), RG_HEAD_DIM ** -0.5),
        "rg_b_a": nrm(ks[12], (N_RG, D_RNN), 0.01),
        "rg_w_x": nrm(ks[13], (N_RG, RG_HEADS, RG_HEAD_DIM, RG_HEAD_DIM), RG_HEAD_DIM ** -0.5),
        "rg_b_x": nrm(ks[14], (N_RG, D_RNN), 0.01),
        "rg_lambda": jnp.log(u_lam) - jnp.log1p(-u_lam),
        "rg_w_out": nrm(ks[15], (N_RG, D_RNN, D), D_RNN ** -0.5),
        "gm_w_in": nrm(ks[16], (N_GM, D, 2 * D_G), D ** -0.5),
        "gm_ln_g": 1.0 + nrm(ks[17], (N_GM, D_G), 0.05),
        "gm_ln_b": nrm(ks[18], (N_GM, D_G), 0.01),
        "gm_w_s": nrm(ks[19], (N_GM, GM_GROUPS, CHUNK, CHUNK), CHUNK ** -0.5),
        "gm_b_s": 1.0 + nrm(ks[21], (N_GM, GM_GROUPS, CHUNK), 0.1),
        "gm_w_out": nrm(ks[22], (N_GM, D_G, D), D_G ** -0.5),
    }


def reference(x, c, ada_w, ada_b, norm_pre, norm_post, ffn_w_in, ffn_w_out,
              rg_w_in, rg_conv_w, rg_conv_b, rg_w_a, rg_b_a, rg_w_x, rg_b_x,
              rg_lambda, rg_w_out, gm_w_in, gm_ln_g, gm_ln_b, gm_w_s, gm_b_s,
              gm_w_out):
    B = x.shape[0]
    c_act = jax.nn.silu(c)

    def sublayer(x, l, j, mod, fn, res_w):
        shift, scale, gate = mod[:, j, 0], mod[:, j, 1], mod[:, j, 2]
        h = rmsnorm(x, norm_pre[l, j]) * (1.0 + scale[:, None, :]) + shift[:, None, :]
        o = rmsnorm(fn(h), norm_post[l, j])
        return x + res_w * gate[:, None, :] * o

    for l in range(DEPTH):
        mod = (c_act @ ada_w[l] + ada_b[l]).reshape(B, N_SUB, 3, D_MODEL)
        x = sublayer(x, l, 0, mod, lambda h: swiglu(h, ffn_w_in[l, 0], ffn_w_out[l, 0]), 0.5)
        if l % N_MIXERS == 0:
            k = l // 2
            mix = lambda h: rglru_mixer(h, rg_w_in[k], rg_conv_w[k], rg_conv_b[k],
                                        rg_w_a[k], rg_b_a[k], rg_w_x[k], rg_b_x[k],
                                        rg_lambda[k], rg_w_out[k])
        else:
            k = l // 2
            mix = lambda h: gmlp_mixer(h, gm_w_in[k], gm_ln_g[k], gm_ln_b[k],
                                       gm_w_s[k], gm_b_s[k], gm_w_out[k])
        x = sublayer(x, l, 1, mod, mix, 1.0)
        x = sublayer(x, l, 2, mod, lambda h: swiglu(h, ffn_w_in[l, 1], ffn_w_out[l, 1]), 0.5)
    return x
```

```cpp
#include <hip/hip_runtime.h>
#include <hip/hip_cooperative_groups.h>
#include <cstdio>
namespace cg = cooperative_groups;
namespace pg8 {
#define PG8_LAS __attribute__((address_space(3)))
typedef unsigned short bf16_t;
typedef short bf16x8 __attribute__((ext_vector_type(8)));
typedef float f32x4 __attribute__((ext_vector_type(4)));
typedef unsigned u32x4 __attribute__((ext_vector_type(4)));
constexpr int BM = 256, BK = 64, HALF = 128, HTB = HALF * BK * 2  , STAGE_BYTES = 8 * HTB, NXCD = 8, WGM = 8;

__host__ __device__ __forceinline__ int lds_byte(int r, int c) { const int st = (r >> 4) * 2 + (c >> 5), rr = r & 15, cc = c & 31, ob = rr * 64 + cc * 2; return st * 1024 + (ob ^ (((ob >> 9) & 1) << 5)); }
__host__ __device__ __forceinline__ void stage_rc(int b, int& R, int& C) { const int st = b / 1024, sb = b % 1024, swz = sb ^ (((sb >> 9) & 1) << 5); R = (st >> 1) * 16 + swz / 64; C = (st & 1) * 32 + (swz % 64) / 2; }
__host__ __device__ __forceinline__ int perm32(int rho) { const int n = rho >> 4, i = rho & 15; return 8 * (i >> 2) + 4 * n + (i & 3); }

struct Unit { int pm, pn; };
struct Gemm { const bf16_t* A; const bf16_t* Bt; int M, N, K; };

struct StaticOrder {
    int nM, nN, nwg, G, c;
    __host__ __device__ void init(int M, int N, int G_, int c_) { nM = M / BM; nN = N / BM; nwg = nM * nN; G = G_; c = c_; }
    __host__ __device__ bool next(int i, Unit& u) const {
        const long L = (long)i * G + c; if (L >= nwg) return false;
        int wgid = (int)L; { const int q = nwg / NXCD, r = nwg % NXCD, xcd = wgid % NXCD, off = wgid / NXCD; wgid = (xcd < r ? xcd * (q + 1) : r * (q + 1) + (xcd - r) * q) + off; }
        const int nig = WGM * nN, gid = wgid / nig, fm = gid * WGM, gsz = (nM - fm) < WGM ? (nM - fm) : WGM;
        u.pm = fm + ((wgid % nig) % gsz); u.pn = (wgid % nig) / gsz; return true;
    }
    __device__ __forceinline__ void a_ready(const Unit&) const {}
    __device__ __forceinline__ void done(const Unit&) const {}
};
__device__ __forceinline__ unsigned cvt_pk_bf16(float lo, float hi) { unsigned r; asm volatile("v_cvt_pk_bf16_f32 %0, %1, %2" : "=v"(r) : "v"(lo), "v"(hi)); return r; }
template <class Epi, class Sched, bool STAMP = false>
__device__ __forceinline__ void gemm_phase(PG8_LAS unsigned char* lds, const Gemm g, const Sched& S, const Epi& E, unsigned long long* stamps) {
    int tid_ = threadIdx.x; asm volatile("" : "+v"(tid_)); const int tid = tid_, wid = __builtin_amdgcn_readfirstlane(tid >> 6), lane = tid & 63, wr = wid >> 2, wc = wid & 3, fr = lane & 15, fq = lane >> 4;
    const int K = g.K, nt = K / BK;
    int ts_lo = 0, ts_hi = 0, nts = 0; const unsigned long long rt_entry = STAMP ? (unsigned long long)wall_clock64() : 0ull;
#define PG8_STAMP() do { if (STAMP && wid == 0 && nts < 64) { const unsigned long long _c = (unsigned long long)clock64(); \
        ts_lo = (lane == nts) ? (int)(unsigned)_c : ts_lo; ts_hi = (lane == nts) ? (int)(unsigned)(_c >> 32) : ts_hi; ++nts; } } while (0)
    PG8_STAMP();
    unsigned voffA[2], voffB[2];
#pragma unroll
    for (int i = 0; i < 2; ++i) { int R, C; stage_rc(tid * 16 + i * 8192, R, C); const int Rb = Epi::PERM ? ((R & ~31) + perm32(R & 31)) : R;
        voffA[i] = (unsigned)(R * K + C) * 2u; voffB[i] = (unsigned)(Rb * K + C) * 2u; }
    const size_t kstep = (size_t)(BK * 2);
    const size_t hstep = (size_t)HALF * K * 2;
    const size_t tstep = 2 * hstep;
    const unsigned ldsw = (unsigned)wid * 1024u;
    const int aoff = lds_byte(wr * 64 + fr, fq * 8), boff = lds_byte(wc * 32 + fr, fq * 8);
#define PG8_SA(b, h) (((b) * 2 + (h)) * HTB)
#define PG8_SB(b, h) ((4 + (b) * 2 + (h)) * HTB)
#define PG8_STAGE(bufoff, gbase, voff) do { _Pragma("unroll") for (int _i = 0; _i < 2; ++_i) \
        __builtin_amdgcn_global_load_lds((const unsigned*)((const char*)(gbase) + (voff)[_i]), (PG8_LAS unsigned*)(lds + (bufoff) + ldsw + _i * 8192), 16, 0, 0); } while (0)
#define PG8_LDA(dst, b, h) do { _Pragma("unroll") for (int m = 0; m < 4; ++m) _Pragma("unroll") for (int k = 0; k < 2; ++k) dst[m][k] = *(const PG8_LAS bf16x8*)(lds + PG8_SA(b, h) + aoff + m * 2048 + k * 1024); } while (0)
#define PG8_LDB(dst, b, h) do { _Pragma("unroll") for (int n = 0; n < 2; ++n) _Pragma("unroll") for (int k = 0; k < 2; ++k) dst[n][k] = *(const PG8_LAS bf16x8*)(lds + PG8_SB(b, h) + boff + n * 2048 + k * 1024); } while (0)
#define PG8_MMA(ai, bj, At, Bt) do { __builtin_amdgcn_s_setprio(1); _Pragma("unroll") for (int m = 0; m < 4; ++m) _Pragma("unroll") for (int n = 0; n < 2; ++n) _Pragma("unroll") for (int k = 0; k < 2; ++k) \
        acc[ai][bj][m][n] = __builtin_amdgcn_mfma_f32_16x16x32_bf16(Bt[n][k], At[m][k], acc[ai][bj][m][n], 0, 0, 0); __builtin_amdgcn_s_setprio(0); } while (0)
#define PG8_WAIT_V(n) asm volatile("s_waitcnt vmcnt(" #n ")" ::: "memory")
#define PG8_WAIT_L(n) asm volatile("s_waitcnt lgkmcnt(" #n ")" ::: "memory")
#define PG8_BAR __builtin_amdgcn_s_barrier()
#define PG8_SCHED __builtin_amdgcn_sched_barrier(0)
    Unit cur, nxt; int ui = 0;
    if (!S.next(0, cur)) return;
    f32x4 acc[2][2][4][2];
#pragma unroll
    for (int a = 0; a < 2; ++a)
#pragma unroll
        for (int b = 0; b < 2; ++b)
#pragma unroll
            for (int m = 0; m < 4; ++m)
#pragma unroll
                for (int n = 0; n < 2; ++n) acc[a][b][m][n] = (f32x4){0.f, 0.f, 0.f, 0.f};
    bf16x8 At[4][2], B0[2][2], B1[2][2];
    const char* cA = (const char*)g.A + (size_t)cur.pm * tstep; const char* cB = (const char*)g.Bt + (size_t)cur.pn * tstep;
    S.a_ready(cur);
    PG8_STAGE(PG8_SB(0, 0), cB, voffB); PG8_STAGE(PG8_SA(0, 0), cA, voffA); PG8_STAGE(PG8_SB(0, 1), cB + hstep, voffB); PG8_STAGE(PG8_SA(0, 1), cA + hstep, voffA);
    if (wr == 1) PG8_BAR;
    PG8_WAIT_V(4); PG8_BAR;
    PG8_STAGE(PG8_SB(1, 0), cB + kstep, voffB); PG8_STAGE(PG8_SA(1, 0), cA + kstep, voffA); PG8_STAGE(PG8_SB(1, 1), cB + hstep + kstep, voffB);
    PG8_WAIT_V(6); PG8_BAR;
    PG8_STAMP();
    for (;;) {
        const bool has_next = S.next(ui + 1, nxt);
        const char* nA = has_next ? (const char*)g.A + (size_t)nxt.pm * tstep : cA; const char* nB = has_next ? (const char*)g.Bt + (size_t)nxt.pn * tstep : cB;
        for (int t = 0; t < nt; t += 2) {
            const bool last = (t == nt - 2);
            const char* a1 = cA + (size_t)(t + 1) * kstep;
            const char* a2 = last ? nA : cA + (size_t)(t + 2) * kstep; const char* b2 = last ? nB : cB + (size_t)(t + 2) * kstep;
            const char* a3 = a2 + kstep; const char* b3 = b2 + kstep;
            if (last && has_next) S.a_ready(nxt);
            PG8_LDB(B0, 0, 0); PG8_SCHED; PG8_LDA(At, 0, 0); PG8_STAGE(PG8_SA(1, 1), a1 + hstep, voffA);
            PG8_WAIT_L(8); PG8_BAR; PG8_WAIT_L(0); PG8_MMA(0, 0, At, B0); PG8_BAR; PG8_SCHED;
            PG8_LDB(B1, 0, 1); PG8_STAGE(PG8_SB(0, 0), b2, voffB);
            PG8_BAR; PG8_WAIT_L(0); PG8_MMA(0, 1, At, B1); PG8_BAR;
            PG8_LDA(At, 0, 1); PG8_STAGE(PG8_SA(0, 0), a2, voffA);
            PG8_BAR; PG8_WAIT_L(0); PG8_MMA(1, 0, At, B0); PG8_BAR; PG8_SCHED;
            PG8_STAGE(PG8_SB(0, 1), b2 + hstep, voffB);
            PG8_WAIT_V(6); PG8_BAR; PG8_MMA(1, 1, At, B1); PG8_BAR;
            PG8_LDB(B0, 1, 0); PG8_SCHED; PG8_LDA(At, 1, 0); PG8_STAGE(PG8_SA(0, 1), a2 + hstep, voffA);
            PG8_WAIT_L(8); PG8_BAR; PG8_WAIT_L(0); PG8_MMA(0, 0, At, B0); PG8_BAR; PG8_SCHED;
            PG8_LDB(B1, 1, 1); PG8_STAGE(PG8_SB(1, 0), b3, voffB);
            PG8_BAR; PG8_WAIT_L(0); PG8_MMA(0, 1, At, B1); PG8_BAR;
            PG8_LDA(At, 1, 1); PG8_STAGE(PG8_SA(1, 0), a3, voffA);
            PG8_BAR; PG8_WAIT_L(0); PG8_MMA(1, 0, At, B0); PG8_BAR; PG8_SCHED;
            PG8_STAGE(PG8_SB(1, 1), b3 + hstep, voffB);
            PG8_WAIT_V(6); PG8_BAR; PG8_MMA(1, 1, At, B1); PG8_BAR;
        }
        PG8_STAMP();
        if constexpr (!Epi::AFTER_DRAIN) { E(acc, cur, wr, wc, fr, fq); S.done(cur); }
        PG8_STAMP();
        if (!has_next) break;
#pragma unroll
        for (int a = 0; a < 2; ++a)
#pragma unroll
            for (int b = 0; b < 2; ++b)
#pragma unroll
                for (int m = 0; m < 4; ++m)
#pragma unroll
                    for (int n = 0; n < 2; ++n) acc[a][b][m][n] = (f32x4){0.f, 0.f, 0.f, 0.f};
        cur = nxt; cA = nA; cB = nB; ++ui;
    }
    PG8_WAIT_V(0);
    if (wr == 0) PG8_BAR;
    PG8_BAR;
    if constexpr (Epi::AFTER_DRAIN) { E.fused(acc, cur, wr, wc, fr, fq, lds, wid, lane); S.done(cur); }
    PG8_STAMP();
    if (STAMP && wid == 0) { stamps[lane] = lane < nts ? (((unsigned long long)(unsigned)ts_hi << 32) | (unsigned)ts_lo) : 0ull;
        if (lane == 62) stamps[62] = rt_entry; if (lane == 63) stamps[63] = (unsigned long long)wall_clock64(); }
#undef PG8_STAMP
#undef PG8_SA
#undef PG8_SB
#undef PG8_STAGE
#undef PG8_LDA
#undef PG8_LDB
#undef PG8_MMA
#undef PG8_WAIT_V
#undef PG8_WAIT_L
#undef PG8_BAR
#undef PG8_SCHED
}
}
using namespace pg8;
#define LAS PG8_LAS
typedef unsigned u32x2 __attribute__((ext_vector_type(2)));

constexpr int T = 32768, D = 1024, SEQ = 16384, DFF = 2816, NMOD = 9216;
constexpr float EPS = 1e-6f;
constexpr int LDS_BYTES = 147456;

constexpr size_t OFF_MOD = 0;
constexpr size_t OFF_C2 = OFF_MOD + 294912;
constexpr size_t OFF_SSQ = OFF_C2 + 8192;
constexpr size_t OFF_VSTAT = OFF_SSQ + 2097152;
constexpr size_t OFF_CHA = OFF_VSTAT + 8388608;
constexpr size_t OFF_CHH = OFF_CHA + 1048576;
constexpr size_t OFF_WFI = OFF_CHH + 1048576;
constexpr size_t OFF_WFO = OFF_WFI + 92274688;
constexpr size_t OFF_WRI = OFF_WFO + 46137344;
constexpr size_t OFF_WRG = OFF_WRI + 8388608;
constexpr size_t OFF_WRO = OFF_WRG + 1048576;
constexpr size_t OFF_WGI = OFF_WRO + 4194304;
constexpr size_t OFF_WGS = OFF_WGI + 16777216;
constexpr size_t OFF_WGO = OFF_WGS + 524288;
constexpr size_t OFF_H = OFF_WGO + 8388608;
constexpr size_t OFF_O = OFF_H + 67108864;
constexpr size_t OFF_ACT = OFF_O + 67108864;
constexpr size_t WS_END = OFF_ACT + 268435456;

struct Args {
    const float *x, *c, *ada_w, *ada_b, *norm_pre, *norm_post, *ffn_w_in, *ffn_w_out, *rg_w_in, *rg_conv_w, *rg_conv_b, *rg_w_a, *rg_b_a, *rg_w_x, *rg_b_x, *rg_lambda,
        *rg_w_out, *gm_w_in, *gm_ln_g, *gm_ln_b, *gm_w_s, *gm_b_s, *gm_w_out;
    float* out; unsigned char* ws;
};

__device__ __forceinline__ float bf_lo(unsigned w) { return __uint_as_float(w << 16); }
__device__ __forceinline__ float bf_hi(unsigned w) { return __uint_as_float(w & 0xffff0000u); }
__device__ __forceinline__ bf16_t f2bf(float f) { unsigned u = __float_as_uint(f); u += 0x7FFFu + ((u >> 16) & 1u); return (bf16_t)(u >> 16); }
__device__ __forceinline__ float sigm(float x) { return __builtin_amdgcn_rcpf(1.0f + __expf(-x)); }
__device__ __forceinline__ float silu_f(float x) { return x * sigm(x); }
__device__ __forceinline__ float gelu_t(float x) { return x * sigm(1.5957691216057308f * x * (1.0f + 0.044715f * x * x)); }
__device__ __forceinline__ u32x4 pack8(const f32x4 a, const f32x4 b) { u32x4 w; w.x = cvt_pk_bf16(a[0], a[1]); w.y = cvt_pk_bf16(a[2], a[3]); w.z = cvt_pk_bf16(b[0], b[1]); w.w = cvt_pk_bf16(b[2], b[3]); return w; }
__device__ __forceinline__ void unpack8(const u32x4 w, float (&f)[8]) { f[0] = bf_lo(w.x); f[1] = bf_hi(w.x); f[2] = bf_lo(w.y); f[3] = bf_hi(w.y); f[4] = bf_lo(w.z); f[5] = bf_hi(w.z); f[6] = bf_lo(w.w); f[7] = bf_hi(w.w); }

struct EpiSwiglu {
    static constexpr bool PERM = true, AFTER_DRAIN = false;
    bf16_t* O;
    __device__ __forceinline__ void operator()(const f32x4 (&acc)[2][2][4][2], const Unit& u, int wr, int wc, int fr, int fq) const {
        const int row0 = u.pm * BM + wr * 64 + fr, col0 = u.pn * 128 + wc * 32 + 8 * fq;
#pragma unroll
        for (int ai = 0; ai < 2; ++ai)
#pragma unroll
            for (int m = 0; m < 4; ++m) {
                f32x4 v0, v1;
#pragma unroll
                for (int j = 0; j < 4; ++j) { v0[j] = silu_f(acc[ai][0][m][0][j]) * acc[ai][1][m][0][j]; v1[j] = silu_f(acc[ai][0][m][1][j]) * acc[ai][1][m][1][j]; }
                *(u32x4*)(O + (size_t)(row0 + ai * HALF + m * 16) * DFF + col0) = pack8(v0, v1);
            }
    }
};
struct EpiOutSsq {
    static constexpr bool PERM = true, AFTER_DRAIN = false;
    bf16_t* O; float* ssq;
    __device__ __forceinline__ void operator()(const f32x4 (&acc)[2][2][4][2], const Unit& u, int wr, int wc, int fr, int fq) const {
        const int row0 = u.pm * BM + wr * 64 + fr, col0 = u.pn * BM + wc * 32 + 8 * fq;
#pragma unroll
        for (int ai = 0; ai < 2; ++ai)
#pragma unroll
            for (int m = 0; m < 4; ++m) {
                const int row = row0 + ai * HALF + m * 16; float s = 0.f;
#pragma unroll
                for (int bj = 0; bj < 2; ++bj) { const f32x4 v0 = acc[ai][bj][m][0], v1 = acc[ai][bj][m][1];
                    s += (v0[0] * v0[0] + v0[1] * v0[1]) + (v0[2] * v0[2] + v0[3] * v0[3]) + (v1[0] * v1[0] + v1[1] * v1[1]) + (v1[2] * v1[2] + v1[3] * v1[3]);
                    *(u32x4*)(O + (size_t)row * D + col0 + bj * HALF) = pack8(v0, v1); }
                s += __shfl_xor(s, 16); s += __shfl_xor(s, 32);
                if (fq == 0) ssq[(size_t)row * 16 + u.pn * 4 + wc] = s;
            }
    }
};
template <int GELU> struct EpiSplit {
    static constexpr bool PERM = true, AFTER_DRAIN = false;
    bf16_t* O0; bf16_t* O1; int half; float* vstat;
    __device__ __forceinline__ void operator()(const f32x4 (&acc)[2][2][4][2], const Unit& u, int wr, int wc, int fr, int fq) const {
        int colt = u.pn * BM; bf16_t* base = O0; const bool second = colt >= half; if (second) { base = O1; colt -= half; }
        const int row0 = u.pm * BM + wr * 64 + fr, col0 = colt + wc * 32 + 8 * fq; const int vt = colt >> 8;
#pragma unroll
        for (int ai = 0; ai < 2; ++ai)
#pragma unroll
            for (int m = 0; m < 4; ++m) {
                const int row = row0 + ai * HALF + m * 16; float s = 0.f, q = 0.f;
#pragma unroll
                for (int bj = 0; bj < 2; ++bj) { f32x4 v0 = acc[ai][bj][m][0], v1 = acc[ai][bj][m][1];
                    if (GELU) {
#pragma unroll
                        for (int j = 0; j < 4; ++j) { v0[j] = gelu_t(v0[j]); v1[j] = gelu_t(v1[j]); }
                        s += (v0[0] + v0[1]) + (v0[2] + v0[3]) + (v1[0] + v1[1]) + (v1[2] + v1[3]);
                        q += (v0[0] * v0[0] + v0[1] * v0[1]) + (v0[2] * v0[2] + v0[3] * v0[3]) + (v1[0] * v1[0] + v1[1] * v1[1]) + (v1[2] * v1[2] + v1[3] * v1[3]); }
                    *(u32x4*)(base + (size_t)row * half + col0 + bj * HALF) = pack8(v0, v1); }
                if (GELU) { s += __shfl_xor(s, 16); s += __shfl_xor(s, 32); q += __shfl_xor(q, 16); q += __shfl_xor(q, 32);
                    if (second && fq == 0) { float* p = vstat + ((size_t)row * 32 + vt * 4 + wc) * 2; p[0] = s; p[1] = q; } }
            }
    }
};

__device__ __forceinline__ void prep_phase(const Args& a, LAS unsigned char* lds) {
    int tid_ = threadIdx.x; asm volatile("" : "+v"(tid_)); const int tid = tid_, wid = tid >> 6, lane = tid & 63;
    float* MOD = (float*)(a.ws + OFF_MOD);
    {
        LAS float* sc = (LAS float*)lds;
        LAS float* red = sc + 2048;
        for (int i = tid; i < 2048; i += 512) sc[i] = silu_f(a.c[i]);
        __syncthreads();
        for (int it = blockIdx.x; it < 576; it += gridDim.x) {
            const int l = it / 144, nb = it % 144;
            const float* w = a.ada_w + ((size_t)l * 1024 + wid * 128) * NMOD + nb * 64 + lane;
            float a0 = 0.f, a1 = 0.f;
#pragma unroll 16
            for (int k = 0; k < 128; ++k) { const float wv = w[(size_t)k * NMOD]; a0 += sc[wid * 128 + k] * wv; a1 += sc[1024 + wid * 128 + k] * wv; }
            red[(wid * 64 + lane) * 2] = a0; red[(wid * 64 + lane) * 2 + 1] = a1;
            __syncthreads();
            if (tid < 128) { const int ln = tid & 63, b = tid >> 6; float s = 0.f;
#pragma unroll
                for (int w2 = 0; w2 < 8; ++w2) s += red[(w2 * 64 + ln) * 2 + b];
                MOD[(size_t)(l * 2 + b) * NMOD + nb * 64 + ln] = s + a.ada_b[(size_t)l * NMOD + nb * 64 + ln]; }
            __syncthreads();
        }
    }
    {
        LAS float* L = (LAS float*)lds;
        for (int tix = blockIdx.x; tix < 5376; tix += gridDim.x) {
            int t = tix, K, N, mode = 0; const float* src; bf16_t* dst;
            if (t < 2816) { const int mi = t / 352; t %= 352; src = a.ffn_w_in + (size_t)mi * 1024 * 5632; dst = (bf16_t*)(a.ws + OFF_WFI) + (size_t)mi * 5632 * 1024; K = 1024; N = 5632; mode = 1; }
            else if ((t -= 2816) < 1408) { const int mi = t / 176; t %= 176; src = a.ffn_w_out + (size_t)mi * 2816 * 1024; dst = (bf16_t*)(a.ws + OFF_WFO) + (size_t)mi * 1024 * 2816; K = 2816; N = 1024; }
            else if ((t -= 1408) < 256) { const int mi = t / 128; t %= 128; src = a.rg_w_in + (size_t)mi * 1024 * 2048; dst = (bf16_t*)(a.ws + OFF_WRI) + (size_t)mi * 2048 * 1024; K = 1024; N = 2048; }
            else if ((t -= 256) < 128) { const int mi = t / 64; t %= 64; src = a.rg_w_out + (size_t)mi * 1024 * 1024; dst = (bf16_t*)(a.ws + OFF_WRO) + (size_t)mi * 1024 * 1024; K = 1024; N = 1024; }
            else if ((t -= 128) < 512) { const int mi = t / 256; t %= 256; src = a.gm_w_in + (size_t)mi * 1024 * 4096; dst = (bf16_t*)(a.ws + OFF_WGI) + (size_t)mi * 4096 * 1024; K = 1024; N = 4096; }
            else { t -= 512; const int mi = t / 128; t %= 128; src = a.gm_w_out + (size_t)mi * 2048 * 1024; dst = (bf16_t*)(a.ws + OFF_WGO) + (size_t)mi * 1024 * 2048; K = 2048; N = 1024; }
            const int ntn = N >> 8, kt = t / ntn, nt = t % ntn, k0 = kt * 64, n0 = nt * 256;
            f32x4 v[8];
#pragma unroll
            for (int i = 0; i < 8; ++i) { const int idx = tid + 512 * i, row = idx >> 6, c4 = idx & 63; v[i] = *(const f32x4*)(src + (size_t)(k0 + row) * N + n0 + c4 * 4); }
#pragma unroll
            for (int i = 0; i < 8; ++i) { const int idx = tid + 512 * i, row = idx >> 6, c4 = idx & 63; *(LAS f32x4*)(L + row * 260 + c4 * 4) = v[i]; }
            __syncthreads();
            const int n = tid & 255, kh = tid >> 8, c = n0 + n; int drow = c;
            if (mode == 1) { const int up = c >= 2816, cc = up ? c - 2816 : c; drow = (cc >> 7) * 256 + up * 128 + (cc & 127); }
            bf16_t* dp = dst + (size_t)drow * K + k0 + kh * 32;
#pragma unroll
            for (int p = 0; p < 4; ++p) { f32x4 f0, f1;
#pragma unroll
                for (int j = 0; j < 4; ++j) { f0[j] = L[(kh * 32 + p * 8 + j) * 260 + n]; f1[j] = L[(kh * 32 + p * 8 + 4 + j) * 260 + n]; }
                *(u32x4*)(dp + p * 8) = pack8(f0, f1); }
            __syncthreads();
        }
    }
    {
        bf16_t* WRG = (bf16_t*)(a.ws + OFF_WRG);
        for (int idx = blockIdx.x * 512 + tid; idx < 524288; idx += gridDim.x * 512) {
            const int d = idx & 127, e = (idx >> 7) & 127, which = (idx >> 14) & 1, h = (idx >> 15) & 7, k2 = idx >> 18;
            const float* s = (which ? a.rg_w_x : a.rg_w_a) + (((size_t)(k2 * 8 + h) * 128 + d) * 128 + e);
            WRG[idx] = f2bf(*s);
        }
    }
    {
        bf16_t* WGS = (bf16_t*)(a.ws + OFF_WGS); float* C2 = (float*)(a.ws + OFF_C2);
        for (int row = blockIdx.x * 8 + wid; row < 2048; row += gridDim.x * 8) {
            const int t = row & 127; float sum = 0.f;
#pragma unroll
            for (int s = lane; s < 128; s += 64) { float w = a.gm_w_s[(size_t)row * 128 + s]; if (s > t) w = 0.f; WGS[(size_t)row * 128 + s] = f2bf(w); sum += w; }
#pragma unroll
            for (int o = 32; o >= 1; o >>= 1) sum += __shfl_xor(sum, o);
            if (lane == 0) C2[row] = sum;
        }
    }
}

__device__ __forceinline__ void ew_phase(const Args& a, int sp, int sn, const float* xin, float* xout) {
    int tid_ = threadIdx.x; asm volatile("" : "+v"(tid_)); const int tid = tid_, wid = tid >> 6, lane = tid & 63;
    const float* MOD = (const float*)(a.ws + OFF_MOD); const float* SSQ = (const float*)(a.ws + OFF_SSQ);
    const bf16_t* O = (const bf16_t*)(a.ws + OFF_O); bf16_t* H = (bf16_t*)(a.ws + OFF_H);
    for (int rb = blockIdx.x * 8 + wid; rb < T / 16; rb += gridDim.x * 8) {
        const int row0 = rb * 16, b = row0 >> 14;
        f32x4 pg[4], ps[4], pb[4];
#pragma unroll
        for (int k = 0; k < 4; ++k) { pg[k] = (f32x4){0.f, 0.f, 0.f, 0.f}; ps[k] = pg[k]; pb[k] = pg[k]; }
        if (sp >= 0) { const int l = sp / 3, j = sp % 3; const float resw = (j == 1) ? 1.0f : 0.5f;
            const float* gate = MOD + (size_t)(l * 2 + b) * NMOD + j * 3072 + 2048 + 4 * lane; const float* gp = a.norm_post + (size_t)(l * 3 + j) * D + 4 * lane;
#pragma unroll
            for (int k = 0; k < 4; ++k) pg[k] = resw * (*(const f32x4*)(gate + 256 * k)) * (*(const f32x4*)(gp + 256 * k)); }
        if (sn >= 0) { const int l = sn / 3, j = sn % 3;
            const float* shift = MOD + (size_t)(l * 2 + b) * NMOD + j * 3072 + 4 * lane; const float* gpre = a.norm_pre + (size_t)(l * 3 + j) * D + 4 * lane;
#pragma unroll
            for (int k = 0; k < 4; ++k) { ps[k] = (*(const f32x4*)(gpre + 256 * k)) * (1.0f + *(const f32x4*)(shift + 1024 + 256 * k)); pb[k] = *(const f32x4*)(shift + 256 * k); } }
        for (int rr = 0; rr < 16; ++rr) {
            const size_t ro = (size_t)(row0 + rr) * D + 4 * lane;
            f32x4 x[4];
#pragma unroll
            for (int k = 0; k < 4; ++k) x[k] = *(const f32x4*)(xin + ro + 256 * k);
            if (sp >= 0) {
                float s = SSQ[(size_t)(row0 + rr) * 16 + (lane & 15)];
                s += __shfl_xor(s, 1); s += __shfl_xor(s, 2); s += __shfl_xor(s, 4); s += __shfl_xor(s, 8);
                const float rstd = rsqrtf(s * (1.0f / 1024.0f) + EPS);
#pragma unroll
                for (int k = 0; k < 4; ++k) { const u32x2 ow = *(const u32x2*)(O + ro + 256 * k); const f32x4 o = (f32x4){bf_lo(ow.x), bf_hi(ow.x), bf_lo(ow.y), bf_hi(ow.y)};
                    x[k] += pg[k] * (o * rstd); *(f32x4*)(xout + ro + 256 * k) = x[k]; }
            }
            if (sn >= 0) {
                float ss = 0.f;
#pragma unroll
                for (int k = 0; k < 4; ++k) ss += (x[k][0] * x[k][0] + x[k][1] * x[k][1]) + (x[k][2] * x[k][2] + x[k][3] * x[k][3]);
#pragma unroll
                for (int o = 32; o >= 1; o >>= 1) ss += __shfl_xor(ss, o);
                const float rs = rsqrtf(ss * (1.0f / 1024.0f) + EPS);
#pragma unroll
                for (int k = 0; k < 4; ++k) { const f32x4 hv = (x[k] * rs) * ps[k] + pb[k]; u32x2 w; w.x = cvt_pk_bf16(hv[0], hv[1]); w.y = cvt_pk_bf16(hv[2], hv[3]); *(u32x2*)(H + ro + 256 * k) = w; }
            }
        }
    }
}

__device__ __forceinline__ void rg_scan_phase(const Args& a, int k2, LAS unsigned char* lds) {
    int tid_ = threadIdx.x; asm volatile("" : "+v"(tid_)); const int tid = tid_, wid = tid >> 6, lane = tid & 63, fr = lane & 15, fq = lane >> 4;
    LAS float* XC = (LAS float*)lds; LAS float* SA = XC + 128 * 132; LAS float* SEG = SA + 128 * 132;
    const bf16_t* XB = (const bf16_t*)(a.ws + OFF_ACT); bf16_t* HLOC = (bf16_t*)(a.ws + OFF_ACT) + (size_t)2 * T * D; bf16_t* APROD = (bf16_t*)(a.ws + OFF_ACT) + (size_t)3 * T * D;
    float* CHA = (float*)(a.ws + OFF_CHA); float* CHH = (float*)(a.ws + OFF_CHH);
    const float* cw = a.rg_conv_w + (size_t)k2 * 4 * D; const float* cb = a.rg_conv_b + (size_t)k2 * D;
    for (int ui = blockIdx.x; ui < 2048; ui += gridDim.x) {
        const int ch = ui >> 3, h = ui & 7, t0 = ch * 128; const bool first = (t0 & (SEQ - 1)) == 0;
        {
            const int cg8 = tid & 15, tq = tid >> 4, c0 = h * 128 + cg8 * 8;
            float w[4][8], bias[8], xr[7][8];
#pragma unroll
            for (int k = 0; k < 4; ++k) { const f32x4 w0 = *(const f32x4*)(cw + k * D + c0), w1 = *(const f32x4*)(cw + k * D + c0 + 4);
#pragma unroll
                for (int j = 0; j < 4; ++j) { w[k][j] = w0[j]; w[k][4 + j] = w1[j]; } }
            { const f32x4 b0 = *(const f32x4*)(cb + c0), b1 = *(const f32x4*)(cb + c0 + 4);
#pragma unroll
                for (int j = 0; j < 4; ++j) { bias[j] = b0[j]; bias[4 + j] = b1[j]; } }
#pragma unroll
            for (int r = 0; r < 7; ++r) { const int tt = 4 * tq - 3 + r;
                if (tt < 0 && first) {
#pragma unroll
                    for (int j = 0; j < 8; ++j) xr[r][j] = 0.f; }
                else { const u32x4 q = *(const u32x4*)(XB + (size_t)(t0 + tt) * D + c0); unpack8(q, xr[r]); } }
#pragma unroll
            for (int q = 0; q < 4; ++q) { f32x4 o0, o1;
#pragma unroll
                for (int j = 0; j < 4; ++j) {
                    o0[j] = bias[j] + w[0][j] * xr[q][j] + w[1][j] * xr[q + 1][j] + w[2][j] * xr[q + 2][j] + w[3][j] * xr[q + 3][j];
                    o1[j] = bias[4 + j] + w[0][4 + j] * xr[q][4 + j] + w[1][4 + j] * xr[q + 1][4 + j] + w[2][4 + j] * xr[q + 2][4 + j] + w[3][4 + j] * xr[q + 3][4 + j]; }
                *(LAS f32x4*)(XC + (4 * tq + q) * 132 + cg8 * 8) = o0; *(LAS f32x4*)(XC + (4 * tq + q) * 132 + cg8 * 8 + 4) = o1; }
        }
        __syncthreads();
        f32x4 bval[8];
        const int cl = 16 * wid + 4 * fq;
        {
            const bf16_t* Wg = (const bf16_t*)(a.ws + OFF_WRG) + (size_t)(k2 * 8 + h) * 256 * 128;
            bf16x8 bfr[2][4];
#pragma unroll
            for (int wh = 0; wh < 2; ++wh)
#pragma unroll
                for (int ks = 0; ks < 4; ++ks) bfr[wh][ks] = *(const bf16x8*)(Wg + (size_t)(wh * 128 + 16 * wid + fr) * 128 + 32 * ks + 8 * fq);
            const int c = k2 * D + h * 128 + cl;
            const f32x4 ba = *(const f32x4*)(a.rg_b_a + c), bx = *(const f32x4*)(a.rg_b_x + c), lam = *(const f32x4*)(a.rg_lambda + c);
            f32x4 nsp;
#pragma unroll
            for (int j = 0; j < 4; ++j) nsp[j] = -8.0f * log1pf(expf(-lam[j]));
#pragma unroll
            for (int mb = 0; mb < 8; ++mb) {
                f32x4 accR = (f32x4){0.f, 0.f, 0.f, 0.f}, accI = accR;
#pragma unroll
                for (int ks = 0; ks < 4; ++ks) { const LAS float* p = XC + (16 * mb + fr) * 132 + 32 * ks + 8 * fq;
                    const f32x4 v0 = *(const LAS f32x4*)p, v1 = *(const LAS f32x4*)(p + 4); const u32x4 pk = pack8(v0, v1); const bf16x8 af = __builtin_bit_cast(bf16x8, pk);
                    accR = __builtin_amdgcn_mfma_f32_16x16x32_bf16(bfr[0][ks], af, accR, 0, 0, 0); accI = __builtin_amdgcn_mfma_f32_16x16x32_bf16(bfr[1][ks], af, accI, 0, 0, 0); }
                const int t = 16 * mb + fr; const f32x4 xc = *(const LAS f32x4*)(XC + t * 132 + cl); f32x4 av;
#pragma unroll
                for (int j = 0; j < 4; ++j) { const float r = sigm(accR[j] + ba[j]), ig = sigm(accI[j] + bx[j]); const float la = nsp[j] * r;
                    av[j] = expf(la); bval[mb][j] = sqrtf(-expm1f(2.0f * la)) * (ig * xc[j]); }
                *(LAS f32x4*)(SA + t * 132 + cl) = av;
            }
        }
        __syncthreads();
#pragma unroll
        for (int mb = 0; mb < 8; ++mb) *(LAS f32x4*)(XC + (16 * mb + fr) * 132 + cl) = bval[mb];
        __syncthreads();
        {
            const int c = tid & 127, sg = tid >> 7;
            float A = 1.f, Hh = 0.f;
#pragma unroll 8
            for (int i = 0; i < 32; ++i) { const int t = 32 * sg + i; const float av = SA[t * 132 + c], bv = XC[t * 132 + c]; Hh = av * Hh + bv; A *= av; }
            SEG[(sg * 128 + c) * 2] = A; SEG[(sg * 128 + c) * 2 + 1] = Hh;
            __syncthreads();
            float Hin = 0.f, Ain = 1.f;
            for (int s2 = 0; s2 < sg; ++s2) { const float As = SEG[(s2 * 128 + c) * 2], Hs = SEG[(s2 * 128 + c) * 2 + 1]; Hin = As * Hin + Hs; Ain *= As; }
            Hh = Hin; float P = Ain;
#pragma unroll 8
            for (int i = 0; i < 32; ++i) { const int t = 32 * sg + i; const float av = SA[t * 132 + c], bv = XC[t * 132 + c]; Hh = av * Hh + bv; P *= av; XC[t * 132 + c] = Hh; SA[t * 132 + c] = P; }
            if (sg == 3) { CHA[(size_t)ch * D + h * 128 + c] = P; CHH[(size_t)ch * D + h * 128 + c] = Hh; }
        }
        __syncthreads();
        {
            const int cg8 = tid & 15, tq = tid >> 4;
#pragma unroll
            for (int i = 0; i < 4; ++i) { const int t = tq + 32 * i; const size_t go = (size_t)(t0 + t) * D + h * 128 + cg8 * 8;
                const LAS float* p = XC + t * 132 + cg8 * 8; *(u32x4*)(HLOC + go) = pack8(*(const LAS f32x4*)p, *(const LAS f32x4*)(p + 4));
                const LAS float* q = SA + t * 132 + cg8 * 8; *(u32x4*)(APROD + go) = pack8(*(const LAS f32x4*)q, *(const LAS f32x4*)(q + 4)); }
        }
        __syncthreads();
    }
}

__device__ __forceinline__ void rg_out_phase(const Args& a, LAS unsigned char* lds) {
    int tid_ = threadIdx.x; asm volatile("" : "+v"(tid_)); const int tid = tid_;
    LAS float* CAR = (LAS float*)lds;
    bf16_t* GB = (bf16_t*)(a.ws + OFF_ACT) + (size_t)T * D; const bf16_t* HLOC = (const bf16_t*)(a.ws + OFF_ACT) + (size_t)2 * T * D; const bf16_t* APROD = (const bf16_t*)(a.ws + OFF_ACT) + (size_t)3 * T * D;
    const float* CHA = (const float*)(a.ws + OFF_CHA); const float* CHH = (const float*)(a.ws + OFF_CHH);
    for (int ch = blockIdx.x; ch < 256; ch += gridDim.x) {
        const int firstc = ch & ~127, t0 = ch * 128;
        float c0 = 0.f, c1 = 0.f;
#pragma unroll 8
        for (int j = firstc; j < ch; ++j) { c0 = CHA[(size_t)j * D + tid] * c0 + CHH[(size_t)j * D + tid]; c1 = CHA[(size_t)j * D + 512 + tid] * c1 + CHH[(size_t)j * D + 512 + tid]; }
        CAR[tid] = c0; CAR[512 + tid] = c1;
        __syncthreads();
        const int cg8 = tid & 127; const f32x4 ca = *(const LAS f32x4*)(CAR + cg8 * 8), cb = *(const LAS f32x4*)(CAR + cg8 * 8 + 4);
        const float car[8] = {ca[0], ca[1], ca[2], ca[3], cb[0], cb[1], cb[2], cb[3]};
#pragma unroll 4
        for (int it = 0; it < 32; ++it) { const int t = (tid >> 7) + 4 * it; const size_t go = (size_t)(t0 + t) * D + cg8 * 8;
            float hl[8], ap[8], gb[8]; unpack8(*(const u32x4*)(HLOC + go), hl); unpack8(*(const u32x4*)(APROD + go), ap); unpack8(*(const u32x4*)(GB + go), gb);
            f32x4 y0, y1;
#pragma unroll
            for (int j = 0; j < 4; ++j) { y0[j] = (hl[j] + ap[j] * car[j]) * gelu_t(gb[j]); y1[j] = (hl[4 + j] + ap[4 + j] * car[4 + j]) * gelu_t(gb[4 + j]); }
            *(u32x4*)(GB + go) = pack8(y0, y1); }
        __syncthreads();
    }
}

__device__ __forceinline__ void gm_gate_phase(const Args& a, int k2, LAS unsigned char* lds) {
    int tid_ = threadIdx.x; asm volatile("" : "+v"(tid_)); const int tid = tid_, wid = tid >> 6, lane = tid & 63, fr = lane & 15, fq = lane >> 4;
    constexpr int VS = 260, AS = 136;
    LAS bf16_t* VT = (LAS bf16_t*)lds;
    LAS bf16_t* AW = VT + 128 * VS;
    LAS float* MU = (LAS float*)(AW + 128 * AS); LAS float* RSTD = MU + 128; LAS float* C1 = RSTD + 128;
    bf16_t* U = (bf16_t*)(a.ws + OFF_ACT); const bf16_t* V = (const bf16_t*)(a.ws + OFF_ACT) + (size_t)T * 2048;
    const float* VSTAT = (const float*)(a.ws + OFF_VSTAT); const float* C2 = (const float*)(a.ws + OFF_C2);
    const bf16_t* WGS = (const bf16_t*)(a.ws + OFF_WGS);
    for (int ch = blockIdx.x; ch < 256; ch += gridDim.x) {
        const int t0 = ch * 128;
        if (tid < 128) { const float* p = VSTAT + (size_t)(t0 + tid) * 64; float s = 0.f, q = 0.f;
#pragma unroll
            for (int i = 0; i < 16; ++i) { const f32x4 v = *(const f32x4*)(p + 4 * i); s += v[0] + v[2]; q += v[1] + v[3]; }
            const float mu = s * (1.0f / 2048.0f), var = fmaxf(q * (1.0f / 2048.0f) - mu * mu, 0.f); MU[tid] = mu; RSTD[tid] = rsqrtf(var + EPS); }
        __syncthreads();
        for (int g = 0; g < 8; ++g) {
            {
                const int t = tid >> 2, sq = tid & 3; const bf16_t* wp = WGS + ((size_t)(k2 * 8 + g) * 128 + t) * 128 + 32 * sq; float c1 = 0.f;
#pragma unroll
                for (int p = 0; p < 4; ++p) { float f[8]; unpack8(*(const u32x4*)(wp + 8 * p), f); f32x4 f0, f1;
#pragma unroll
                    for (int j = 0; j < 4; ++j) { f0[j] = f[j] * RSTD[32 * sq + 8 * p + j]; f1[j] = f[4 + j] * RSTD[32 * sq + 8 * p + 4 + j]; }
                    const u32x4 pk = pack8(f0, f1); float fr8[8]; unpack8(pk, fr8);
#pragma unroll
                    for (int j = 0; j < 8; ++j) c1 += fr8[j] * MU[32 * sq + 8 * p + j];
                    *(LAS u32x4*)(AW + t * AS + 32 * sq + 8 * p) = pk; }
                c1 += __shfl_xor(c1, 1); c1 += __shfl_xor(c1, 2);
                if (sq == 0) C1[t] = c1;
            }
            {
#pragma unroll
                for (int i = 0; i < 8; ++i) { const int item = tid + 512 * i, row = item >> 5, c16 = item & 31;
                    const u32x4 q = *(const u32x4*)(V + (size_t)(t0 + row) * 2048 + g * 256 + 8 * c16);
                    LAS u32x2* dp = (LAS u32x2*)(VT + row * VS + 8 * c16); dp[0] = (u32x2){q.x, q.y}; dp[1] = (u32x2){q.z, q.w}; }
            }
            __syncthreads();
            f32x4 acc[8][2];
#pragma unroll
            for (int mb = 0; mb < 8; ++mb) { acc[mb][0] = (f32x4){0.f, 0.f, 0.f, 0.f}; acc[mb][1] = acc[mb][0]; }
#pragma unroll
            for (int ks = 0; ks < 4; ++ks) {
                bf16x8 vf[2];
#pragma unroll
                for (int nb = 0; nb < 2; ++nb) { const LAS bf16_t* vp = VT + (32 * ks + 8 * fq) * VS + 32 * wid + 16 * nb + fr;
#pragma unroll
                    for (int j = 0; j < 8; ++j) vf[nb][j] = (short)vp[j * VS]; }
#pragma unroll
                for (int mb = 0; mb < 8; ++mb) if (16 * mb + 15 >= 32 * ks) {
                    const bf16x8 af = *(const LAS bf16x8*)(AW + (16 * mb + fr) * AS + 32 * ks + 8 * fq);
                    acc[mb][0] = __builtin_amdgcn_mfma_f32_16x16x32_bf16(vf[0], af, acc[mb][0], 0, 0, 0);
                    acc[mb][1] = __builtin_amdgcn_mfma_f32_16x16x32_bf16(vf[1], af, acc[mb][1], 0, 0, 0); }
            }
            const int d0 = g * 256 + 32 * wid + 4 * fq;
            f32x4 gd[2], bd[2];
#pragma unroll
            for (int nb = 0; nb < 2; ++nb) { gd[nb] = *(const f32x4*)(a.gm_ln_g + (size_t)k2 * 2048 + d0 + 16 * nb); bd[nb] = *(const f32x4*)(a.gm_ln_b + (size_t)k2 * 2048 + d0 + 16 * nb); }
#pragma unroll
            for (int mb = 0; mb < 8; ++mb) { const int t = 16 * mb + fr; const float c1t = C1[t], c2t = C2[(k2 * 8 + g) * 128 + t], bst = a.gm_b_s[(size_t)(k2 * 8 + g) * 128 + t];
#pragma unroll
                for (int nb = 0; nb < 2; ++nb) { bf16_t* up = U + (size_t)(t0 + t) * 2048 + d0 + 16 * nb; const u32x2 uw = *(const u32x2*)up;
                    const f32x4 uv = (f32x4){bf_lo(uw.x), bf_hi(uw.x), bf_lo(uw.y), bf_hi(uw.y)};
                    const f32x4 vm = gd[nb] * (acc[mb][nb] - c1t) + bd[nb] * c2t + bst; const f32x4 y = uv * vm;
                    u32x2 w; w.x = cvt_pk_bf16(y[0], y[1]); w.y = cvt_pk_bf16(y[2], y[3]); *(u32x2*)up = w; } }
            __syncthreads();
        }
    }
}

template <class Epi> __device__ __forceinline__ void run_gemm(LAS unsigned char* lds, const bf16_t* A, const bf16_t* Bt, int N, int K, const Epi& E) {
    StaticOrder S; S.init(T, N, (int)gridDim.x, (int)blockIdx.x);
    Gemm g; g.A = A; g.Bt = Bt; g.M = T; g.N = N; g.K = K;
    gemm_phase<Epi, StaticOrder, false>(lds, g, S, E, nullptr);
}

__global__ void __launch_bounds__(512) fwd_megakernel(Args a) {
    extern __shared__ __attribute__((aligned(16))) unsigned char shm[];
    LAS unsigned char* lds = (LAS unsigned char*)shm;
    cg::grid_group grid = cg::this_grid();
    bf16_t* H = (bf16_t*)(a.ws + OFF_H); bf16_t* O = (bf16_t*)(a.ws + OFF_O); bf16_t* ACT = (bf16_t*)(a.ws + OFF_ACT);
    float* SSQ = (float*)(a.ws + OFF_SSQ);

#ifndef NO_PREP
    prep_phase(a, lds);
#endif
    grid.sync();
#ifndef NO_EW
    ew_phase(a, -1, 0, a.x, a.out);
#endif
    grid.sync();
    for (int si = 0; si < 12; ++si) {
        const int l = si / 3, j = si % 3, k2 = l >> 1;
        const int type = (j != 1) ? 0 : ((l & 1) ? 2 : 1);
        const bf16_t* A2; const bf16_t* B2; int K2;
        if (type == 0) {
            const int fi = l * 2 + (j >> 1);
            EpiSwiglu e; e.O = ACT;
#ifndef NO_G1
            run_gemm(lds, H, (const bf16_t*)(a.ws + OFF_WFI) + (size_t)fi * 5632 * 1024, 5632, 1024, e);
#endif
            A2 = ACT; B2 = (const bf16_t*)(a.ws + OFF_WFO) + (size_t)fi * 1024 * 2816; K2 = 2816;
            grid.sync();
        } else if (type == 1) {
            EpiSplit<0> e; e.O0 = ACT; e.O1 = ACT + (size_t)T * D; e.half = 1024; e.vstat = nullptr;
#ifndef NO_R1
            run_gemm(lds, H, (const bf16_t*)(a.ws + OFF_WRI) + (size_t)k2 * 2048 * 1024, 2048, 1024, e);
#endif
            grid.sync();
#ifndef NO_R2
            rg_scan_phase(a, k2, lds);
#endif
            grid.sync();
#ifndef NO_R3
            rg_out_phase(a, lds);
#endif
            A2 = ACT + (size_t)T * D; B2 = (const bf16_t*)(a.ws + OFF_WRO) + (size_t)k2 * 1024 * 1024; K2 = 1024;
            grid.sync();
        } else {
            EpiSplit<1> e; e.O0 = ACT; e.O1 = ACT + (size_t)T * 2048; e.half = 2048; e.vstat = (float*)(a.ws + OFF_VSTAT);
#ifndef NO_M1
            run_gemm(lds, H, (const bf16_t*)(a.ws + OFF_WGI) + (size_t)k2 * 4096 * 1024, 4096, 1024, e);
#endif
            grid.sync();
#ifndef NO_M2
            gm_gate_phase(a, k2, lds);
#endif
            A2 = ACT; B2 = (const bf16_t*)(a.ws + OFF_WGO) + (size_t)k2 * 1024 * 2048; K2 = 2048;
            grid.sync();
        }
#ifndef NO_G2
        { EpiOutSsq e; e.O = O; e.ssq = SSQ; run_gemm(lds, A2, B2, 1024, K2, e); }
#endif
        grid.sync();
#ifndef NO_EW
        ew_phase(a, si, si < 11 ? si + 1 : -1, si == 0 ? a.x : a.out, a.out);
#endif
        grid.sync();
    }
}

extern "C" void kernel_launch(void* const* d_in, const int* in_sizes, int n_in, void* d_out, int out_size, void* d_ws, size_t ws_size, hipStream_t stream) {
    static int grid_blocks = 0;
    if (grid_blocks == 0) {
        if (n_in != 23 || out_size != T * D || ws_size < WS_END) { fprintf(stderr, "kernel_launch: unexpected shapes (n_in %d out %d ws %zu need %zu)\n", n_in, out_size, ws_size, (size_t)WS_END); grid_blocks = -1; return; }
        int dev = 0, cus = 0, per_cu = 0;
        hipGetDevice(&dev);
        hipDeviceGetAttribute(&cus, hipDeviceAttributeMultiprocessorCount, dev);
        if (hipFuncSetAttribute((const void*)fwd_megakernel, hipFuncAttributeMaxDynamicSharedMemorySize, LDS_BYTES) != hipSuccess) { fprintf(stderr, "kernel_launch: hipFuncSetAttribute failed\n"); (void)hipGetLastError(); }
        if (hipOccupancyMaxActiveBlocksPerMultiprocessor(&per_cu, (const void*)fwd_megakernel, 512, LDS_BYTES) != hipSuccess || per_cu < 1) { fprintf(stderr, "kernel_launch: occupancy query gave %d\n", per_cu); (void)hipGetLastError(); per_cu = 1; }
        grid_blocks = cus * 1;
        if (grid_blocks <= 0) grid_blocks = 256;
    }
    if (grid_blocks < 0) return;
    Args a{};
    const float** ap = (const float**)&a;
    for (int i = 0; i < 23; ++i) ap[i] = (const float*)d_in[i];
    a.out = (float*)d_out; a.ws = (unsigned char*)d_ws;
    void* args[] = {&a};
    hipError_t e = hipLaunchCooperativeKernel((const void*)fwd_megakernel, dim3(grid_blocks), dim3(512), args, LDS_BYTES, stream);
    if (e != hipSuccess) fprintf(stderr, "cooperative launch failed: %s (grid %d)\n", hipGetErrorString(e), grid_blocks);
}
```

```cpp
#include <hip/hip_runtime.h>
#include <hip/hip_cooperative_groups.h>
#include <cstdio>
namespace cg = cooperative_groups;
namespace pg8 {
#define PG8_LAS __attribute__((address_space(3)))
typedef unsigned short bf16_t;
typedef short bf16x8 __attribute__((ext_vector_type(8)));
typedef float f32x4 __attribute__((ext_vector_type(4)));
typedef unsigned u32x4 __attribute__((ext_vector_type(4)));
constexpr int BM = 256, BK = 64, HALF = 128, HTB = HALF * BK * 2  , STAGE_BYTES = 8 * HTB, NXCD = 8, WGM = 4;

__host__ __device__ __forceinline__ int lds_byte(int r, int c) { const int st = (r >> 4) * 2 + (c >> 5), rr = r & 15, cc = c & 31, ob = rr * 64 + cc * 2; return st * 1024 + (ob ^ (((ob >> 9) & 1) << 5)); }
__host__ __device__ __forceinline__ void stage_rc(int b, int& R, int& C) { const int st = b / 1024, sb = b % 1024, swz = sb ^ (((sb >> 9) & 1) << 5); R = (st >> 1) * 16 + swz / 64; C = (st & 1) * 32 + (swz % 64) / 2; }
__host__ __device__ __forceinline__ int perm32(int rho) { const int n = rho >> 4, i = rho & 15; return 8 * (i >> 2) + 4 * n + (i & 3); }

struct Unit { int pm, pn; };
struct Gemm { const bf16_t* A; const bf16_t* Bt; int M, N, K; size_t ars; };

struct StaticOrder {
    int nM, nN, nwg, G, c;
    __host__ __device__ void init(int M, int N, int G_, int c_) { nM = M / BM; nN = N / BM; nwg = nM * nN; G = G_; c = c_; }
    __host__ __device__ bool next(int i, Unit& u) const {
        const long L = (long)i * G + c; if (L >= nwg) return false;
        int wgid = (int)L; { const int q = nwg / NXCD, r = nwg % NXCD, xcd = wgid % NXCD, off = wgid / NXCD; wgid = (xcd < r ? xcd * (q + 1) : r * (q + 1) + (xcd - r) * q) + off; }
        const int nig = WGM * nN, gid = wgid / nig, fm = gid * WGM, gsz = (nM - fm) < WGM ? (nM - fm) : WGM;
        u.pm = fm + ((wgid % nig) % gsz); u.pn = (wgid % nig) / gsz; return true;
    }
    __device__ __forceinline__ void a_ready(const Unit&) const {}
    __device__ __forceinline__ void done(const Unit&) const {}
};
__device__ __forceinline__ unsigned cvt_pk_bf16(float lo, float hi) { unsigned r; asm volatile("v_cvt_pk_bf16_f32 %0, %1, %2" : "=v"(r) : "v"(lo), "v"(hi)); return r; }
template <class Epi, class Sched, bool STAMP = false>
__device__ __forceinline__ void gemm_phase(PG8_LAS unsigned char* lds, const Gemm g, const Sched& S, const Epi& E, unsigned long long* stamps) {
    int tid_ = threadIdx.x; asm volatile("" : "+v"(tid_)); const int tid = tid_, wid = __builtin_amdgcn_readfirstlane(tid >> 6), lane = tid & 63, wr = wid >> 2, wc = wid & 3, fr = lane & 15, fq = lane >> 4;
    const int K = g.K, nt = K / BK;
    int ts_lo = 0, ts_hi = 0, nts = 0; const unsigned long long rt_entry = STAMP ? (unsigned long long)wall_clock64() : 0ull;
#define PG8_STAMP() do { if (STAMP && wid == 0 && nts < 64) { const unsigned long long _c = (unsigned long long)clock64(); \
        ts_lo = (lane == nts) ? (int)(unsigned)_c : ts_lo; ts_hi = (lane == nts) ? (int)(unsigned)(_c >> 32) : ts_hi; ++nts; } } while (0)
    PG8_STAMP();
    unsigned voffA[2], voffB[2];
#pragma unroll
    for (int i = 0; i < 2; ++i) { int R, C; stage_rc(tid * 16 + i * 8192, R, C); const int Rb = Epi::PERM ? ((R & ~31) + perm32(R & 31)) : R;
        voffA[i] = (unsigned)(R * K + C) * 2u; voffB[i] = (unsigned)(Rb * K + C) * 2u; }
    const size_t kstep = (size_t)(BK * 2);
    const size_t hstep = (size_t)HALF * K * 2;
    const size_t tstep = 2 * hstep;
    const unsigned ldsw = (unsigned)wid * 1024u;
    const int aoff = lds_byte(wr * 64 + fr, fq * 8), boff = lds_byte(wc * 32 + fr, fq * 8);
#define PG8_SA(b, h) (((b) * 2 + (h)) * HTB)
#define PG8_SB(b, h) ((4 + (b) * 2 + (h)) * HTB)
#define PG8_STAGE(bufoff, gbase, voff) do { _Pragma("unroll") for (int _i = 0; _i < 2; ++_i) \
        __builtin_amdgcn_global_load_lds((const unsigned*)((const char*)(gbase) + (voff)[_i]), (PG8_LAS unsigned*)(lds + (bufoff) + ldsw + _i * 8192), 16, 0, 0); } while (0)
#define PG8_LDA(dst, b, h) do { _Pragma("unroll") for (int m = 0; m < 4; ++m) _Pragma("unroll") for (int k = 0; k < 2; ++k) dst[m][k] = *(const PG8_LAS bf16x8*)(lds + PG8_SA(b, h) + aoff + m * 2048 + k * 1024); } while (0)
#define PG8_LDB(dst, b, h) do { _Pragma("unroll") for (int n = 0; n < 2; ++n) _Pragma("unroll") for (int k = 0; k < 2; ++k) dst[n][k] = *(const PG8_LAS bf16x8*)(lds + PG8_SB(b, h) + boff + n * 2048 + k * 1024); } while (0)
#define PG8_MMA(ai, bj, At, Bt) do { __builtin_amdgcn_s_setprio(1); _Pragma("unroll") for (int m = 0; m < 4; ++m) _Pragma("unroll") for (int n = 0; n < 2; ++n) _Pragma("unroll") for (int k = 0; k < 2; ++k) \
        acc[ai][bj][m][n] = __builtin_amdgcn_mfma_f32_16x16x32_bf16(Bt[n][k], At[m][k], acc[ai][bj][m][n], 0, 0, 0); __builtin_amdgcn_s_setprio(0); } while (0)
#define PG8_WAIT_V(n) asm volatile("s_waitcnt vmcnt(" #n ")" ::: "memory")
#define PG8_WAIT_L(n) asm volatile("s_waitcnt lgkmcnt(" #n ")" ::: "memory")
#define PG8_BAR __builtin_amdgcn_s_barrier()
#define PG8_SCHED __builtin_amdgcn_sched_barrier(0)
    Unit cur, nxt; int ui = 0;
    if (!S.next(0, cur)) return;
    f32x4 acc[2][2][4][2];
#pragma unroll
    for (int a = 0; a < 2; ++a)
#pragma unroll
        for (int b = 0; b < 2; ++b)
#pragma unroll
            for (int m = 0; m < 4; ++m)
#pragma unroll
                for (int n = 0; n < 2; ++n) acc[a][b][m][n] = (f32x4){0.f, 0.f, 0.f, 0.f};
    bf16x8 At[4][2], B0[2][2], B1[2][2];
    const char* cA = (const char*)g.A + (size_t)(cur.pm >> 4) * g.ars + (size_t)(cur.pm & 15) * tstep; const char* cB = (const char*)g.Bt + (size_t)cur.pn * tstep;
    S.a_ready(cur);
    PG8_STAGE(PG8_SB(0, 0), cB, voffB); PG8_STAGE(PG8_SA(0, 0), cA, voffA); PG8_STAGE(PG8_SB(0, 1), cB + hstep, voffB); PG8_STAGE(PG8_SA(0, 1), cA + hstep, voffA);
    if (wr == 1) PG8_BAR;
    PG8_WAIT_V(4); PG8_BAR;
    PG8_STAGE(PG8_SB(1, 0), cB + kstep, voffB); PG8_STAGE(PG8_SA(1, 0), cA + kstep, voffA); PG8_STAGE(PG8_SB(1, 1), cB + hstep + kstep, voffB);
    PG8_WAIT_V(6); PG8_BAR;
    PG8_STAMP();
    for (;;) {
        const bool has_next = S.next(ui + 1, nxt);
        const char* nA = has_next ? (const char*)g.A + (size_t)(nxt.pm >> 4) * g.ars + (size_t)(nxt.pm & 15) * tstep : cA; const char* nB = has_next ? (const char*)g.Bt + (size_t)nxt.pn * tstep : cB;
        for (int t = 0; t < nt; t += 2) {
            const bool last = (t == nt - 2);
            const char* a1 = cA + (size_t)(t + 1) * kstep;
            const char* a2 = last ? nA : cA + (size_t)(t + 2) * kstep; const char* b2 = last ? nB : cB + (size_t)(t + 2) * kstep;
            const char* a3 = a2 + kstep; const char* b3 = b2 + kstep;
            if (last && has_next) S.a_ready(nxt);
            PG8_LDB(B0, 0, 0); PG8_SCHED; PG8_LDA(At, 0, 0); PG8_STAGE(PG8_SA(1, 1), a1 + hstep, voffA);
            PG8_WAIT_L(8); PG8_BAR; PG8_WAIT_L(0); PG8_MMA(0, 0, At, B0); PG8_BAR; PG8_SCHED;
            PG8_LDB(B1, 0, 1); PG8_STAGE(PG8_SB(0, 0), b2, voffB);
            PG8_BAR; PG8_WAIT_L(0); PG8_MMA(0, 1, At, B1); PG8_BAR;
            PG8_LDA(At, 0, 1); PG8_STAGE(PG8_SA(0, 0), a2, voffA);
            PG8_BAR; PG8_WAIT_L(0); PG8_MMA(1, 0, At, B0); PG8_BAR; PG8_SCHED;
            PG8_STAGE(PG8_SB(0, 1), b2 + hstep, voffB);
            PG8_WAIT_V(6); PG8_BAR; PG8_MMA(1, 1, At, B1); PG8_BAR;
            PG8_LDB(B0, 1, 0); PG8_SCHED; PG8_LDA(At, 1, 0); PG8_STAGE(PG8_SA(0, 1), a2 + hstep, voffA);
            PG8_WAIT_L(8); PG8_BAR; PG8_WAIT_L(0); PG8_MMA(0, 0, At, B0); PG8_BAR; PG8_SCHED;
            PG8_LDB(B1, 1, 1); PG8_STAGE(PG8_SB(1, 0), b3, voffB);
            PG8_BAR; PG8_WAIT_L(0); PG8_MMA(0, 1, At, B1); PG8_BAR;
            PG8_LDA(At, 1, 1); PG8_STAGE(PG8_SA(1, 0), a3, voffA);
            PG8_BAR; PG8_WAIT_L(0); PG8_MMA(1, 0, At, B0); PG8_BAR; PG8_SCHED;
            PG8_STAGE(PG8_SB(1, 1), b3 + hstep, voffB);
            PG8_WAIT_V(6); PG8_BAR; PG8_MMA(1, 1, At, B1); PG8_BAR;
        }
        PG8_STAMP();
        if constexpr (!Epi::AFTER_DRAIN) { E(acc, cur, wr, wc, fr, fq); S.done(cur); }
        PG8_STAMP();
        if (!has_next) break;
#pragma unroll
        for (int a = 0; a < 2; ++a)
#pragma unroll
            for (int b = 0; b < 2; ++b)
#pragma unroll
                for (int m = 0; m < 4; ++m)
#pragma unroll
                    for (int n = 0; n < 2; ++n) acc[a][b][m][n] = (f32x4){0.f, 0.f, 0.f, 0.f};
        cur = nxt; cA = nA; cB = nB; ++ui;
    }
    PG8_WAIT_V(0);
    if (wr == 0) PG8_BAR;
    PG8_BAR;
    if constexpr (Epi::AFTER_DRAIN) { E.fused(acc, cur, wr, wc, fr, fq, lds, wid, lane); S.done(cur); }
    PG8_STAMP();
    if (STAMP && wid == 0) { stamps[lane] = lane < nts ? (((unsigned long long)(unsigned)ts_hi << 32) | (unsigned)ts_lo) : 0ull;
        if (lane == 62) stamps[62] = rt_entry; if (lane == 63) stamps[63] = (unsigned long long)wall_clock64(); }
#undef PG8_STAMP
#undef PG8_SA
#undef PG8_SB
#undef PG8_STAGE
#undef PG8_LDA
#undef PG8_LDB
#undef PG8_MMA
#undef PG8_WAIT_V
#undef PG8_WAIT_L
#undef PG8_BAR
#undef PG8_SCHED
}
}
#define LAS PG8_LAS
#define XB_TMO      128
#define XB_XCNT(j)  (256  + 64 * (j))
#define XB_XSUB(j)  (1280 + 64 * (j))
#define XB_XGEN(j)  (2304 + 64 * (j))
#define XB_TOP      3328
#define XB_TOPGEN   3392
#define XCD_BAR_WORDS 3456
#define XB_SPIN_CAP (1u << 18)

__device__ __forceinline__ unsigned xb_ld(unsigned* p)              { return __hip_atomic_load(p, __ATOMIC_RELAXED, __HIP_MEMORY_SCOPE_AGENT); }
__device__ __forceinline__ unsigned xb_add(unsigned* p, unsigned v) { return __hip_atomic_fetch_add(p, v, __ATOMIC_RELAXED, __HIP_MEMORY_SCOPE_AGENT); }
__device__ __forceinline__ unsigned xb_xcc_id() { return (unsigned)__builtin_amdgcn_s_getreg((3 << 11) | 20) & 0xFu; }
#define XB_SPIN(cond, bar) do { unsigned _sp = 0; while (cond) { __builtin_amdgcn_s_sleep(1); \
    if ((++_sp & 255u) == 0u) { if (xb_ld(&(bar)[XB_TMO])) break; if (_sp > XB_SPIN_CAP) { atomicAdd(&(bar)[XB_TMO], 1u); break; } } } } while (0)

struct XcdBarrier {
    unsigned* bar; unsigned x;
    volatile LAS unsigned* st;
};

__device__ __forceinline__ XcdBarrier xcd_barrier_post(unsigned* bar, volatile LAS unsigned* st) {
    XcdBarrier b; b.bar = bar; b.x = xb_xcc_id(); b.st = st;
    if (threadIdx.x == 0) (void)xb_add(&bar[XB_XCNT(b.x)], 1u);
    return b;
}
__device__ __forceinline__ void xcd_barrier_complete(unsigned* bar, unsigned x, unsigned& nloc, unsigned& nx) {
    const unsigned G = gridDim.x * gridDim.y * gridDim.z;
    unsigned sum, cnt, mine, sp = 0u;
    for (;;) {
        sum = 0u; cnt = 0u; mine = 0u;
#pragma unroll
        for (unsigned j = 0; j < 16; ++j) { const unsigned c = xb_ld(&bar[XB_XCNT(j)]); sum += c; cnt += (c > 0u) ? 1u : 0u; mine = (j == x) ? c : mine; }
        if (sum == G) break;
        __builtin_amdgcn_s_sleep(1);
        if ((++sp & 255u) == 0u) { if (xb_ld(&bar[XB_TMO])) break; if (sp > XB_SPIN_CAP) { atomicAdd(&bar[XB_TMO], 1u); break; } }
    }
    nloc = mine > 0u ? mine : 1u; nx = cnt > 0u ? cnt : 1u;
}

__device__ __forceinline__ void xcd_barrier(const XcdBarrier& b) {
    asm volatile("s_waitcnt vmcnt(0)" ::: "memory");
    __syncthreads();
    if (threadIdx.x == 0) {
        unsigned* bar = b.bar;
        __builtin_amdgcn_s_waitcnt(0);
        unsigned nloc = b.st[0], nx = b.st[1];
        if (nloc == 0u) { xcd_barrier_complete(bar, b.x, nloc, nx); b.st[0] = nloc; b.st[1] = nx; }
        const unsigned old = xb_add(&bar[XB_XSUB(b.x)], 1u);
        const unsigned gen = old / nloc;
        if (old + 1u == (gen + 1u) * nloc) {
            __builtin_amdgcn_fence(__ATOMIC_RELEASE, "agent");
            asm volatile("s_waitcnt vmcnt(0)" ::: "memory");
            const unsigned og = xb_add(&bar[XB_TOP], 1u);
            const unsigned tg = og / nx;
            if (og + 1u == (tg + 1u) * nx) xb_add(&bar[XB_TOPGEN], 1u);
            else XB_SPIN(xb_ld(&bar[XB_TOPGEN]) == tg, bar);
            __builtin_amdgcn_fence(__ATOMIC_ACQUIRE, "agent");
            xb_add(&bar[XB_XGEN(b.x)], 1u);
            asm volatile("s_waitcnt vmcnt(0)" ::: "memory");
        } else {
            XB_SPIN(xb_ld(&bar[XB_XGEN(b.x)]) == gen, bar);
            __builtin_amdgcn_fence(__ATOMIC_ACQUIRE, "agent");
            asm volatile("s_waitcnt vmcnt(0)" ::: "memory");
        }
    }
    __syncthreads();
}

using namespace pg8;
#define LAS PG8_LAS
typedef unsigned u32x2 __attribute__((ext_vector_type(2)));

constexpr int T = 32768, D = 1024, SEQ = 16384, DFF = 2816, NMOD = 9216;
constexpr float EPS = 1e-6f;
constexpr int LDS_BYTES = 147456;

constexpr size_t OFF_MOD = 0;
constexpr size_t OFF_C2 = OFF_MOD + 294912;
constexpr size_t OFF_SSQ = OFF_C2 + 8192;
constexpr size_t OFF_VSTAT = OFF_SSQ + 2097152;
constexpr size_t OFF_CHA = OFF_VSTAT + 8388608;
constexpr size_t OFF_CHH = OFF_CHA + 1048576;
constexpr size_t OFF_WFI = OFF_CHH + 1048576;
constexpr size_t OFF_WFO = OFF_WFI + 92274688;
constexpr size_t OFF_WRI = OFF_WFO + 46137344;
constexpr size_t OFF_WRG = OFF_WRI + 8388608;
constexpr size_t OFF_WRO = OFF_WRG + 1048576;
constexpr size_t OFF_WGI = OFF_WRO + 4194304;
constexpr size_t OFF_WGS = OFF_WGI + 16777216;
constexpr size_t OFF_WGO = OFF_WGS + 524288;
constexpr size_t OFF_H = OFF_WGO + 8388608;
constexpr size_t OFF_O = OFF_H + 67108864;
constexpr size_t OFF_ACT = OFF_O + 67108864;
constexpr size_t OFF_BAR = OFF_ACT + 268435456;
constexpr size_t OFF_LOC = OFF_BAR + 16384;
constexpr size_t OFF_NSP = OFF_LOC + 4096;
constexpr size_t OFF_O2 = OFF_NSP + 8192;
constexpr size_t OFF_SSQ2 = OFF_O2 + 67108864;
constexpr size_t WS_END = OFF_SSQ2 + 2097152;
constexpr size_t REGB = 33554432;

struct Args {
    const float *x, *c, *ada_w, *ada_b, *norm_pre, *norm_post, *ffn_w_in, *ffn_w_out, *rg_w_in, *rg_conv_w, *rg_conv_b, *rg_w_a, *rg_b_a, *rg_w_x, *rg_b_x, *rg_lambda,
        *rg_w_out, *gm_w_in, *gm_ln_g, *gm_ln_b, *gm_w_s, *gm_b_s, *gm_w_out;
    float* out; unsigned char* ws;
};

__device__ __forceinline__ float bf_lo(unsigned w) { return __uint_as_float(w << 16); }
__device__ __forceinline__ float bf_hi(unsigned w) { return __uint_as_float(w & 0xffff0000u); }
__device__ __forceinline__ bf16_t f2bf(float f) { unsigned u = __float_as_uint(f); u += 0x7FFFu + ((u >> 16) & 1u); return (bf16_t)(u >> 16); }
__device__ __forceinline__ float sigm(float x) { return __builtin_amdgcn_rcpf(1.0f + __expf(-x)); }
__device__ __forceinline__ float silu_f(float x) { return x * sigm(x); }
__device__ __forceinline__ float gelu_t(float x) { const float t = x * fmaf(-0.10294324f, x * x, -2.3022082f); return x * __builtin_amdgcn_rcpf(1.0f + __builtin_amdgcn_exp2f(t)); }
__device__ __forceinline__ u32x4 pack8(const f32x4 a, const f32x4 b) { u32x4 w; w.x = cvt_pk_bf16(a[0], a[1]); w.y = cvt_pk_bf16(a[2], a[3]); w.z = cvt_pk_bf16(b[0], b[1]); w.w = cvt_pk_bf16(b[2], b[3]); return w; }
__device__ __forceinline__ void unpack8(const u32x4 w, float (&f)[8]) { f[0] = bf_lo(w.x); f[1] = bf_hi(w.x); f[2] = bf_lo(w.y); f[3] = bf_hi(w.y); f[4] = bf_lo(w.z); f[5] = bf_hi(w.z); f[6] = bf_lo(w.w); f[7] = bf_hi(w.w); }

__device__ __forceinline__ size_t act_off(int row, int pitchB, size_t sub) { return (size_t)(row >> 12) * REGB + sub + (size_t)(row & 4095) * (size_t)pitchB; }
__device__ __forceinline__ void xcc_local_barrier(unsigned* cnt, unsigned nloc) {
    asm volatile("s_waitcnt vmcnt(0)" ::: "memory");
    __syncthreads();
    if (threadIdx.x == 0) {
        __builtin_amdgcn_s_waitcnt(0);
        const unsigned old = xb_add(cnt, 1u); const unsigned target = (old / nloc + 1u) * nloc; unsigned sp = 0u;
        while (xb_ld(cnt) < target) { __builtin_amdgcn_s_sleep(1); if (++sp > (1u << 20)) break; }
        __builtin_amdgcn_fence(__ATOMIC_ACQUIRE, "agent");
        asm volatile("s_waitcnt vmcnt(0)" ::: "memory");
    }
    __syncthreads();
}

struct EpiSwiglu {
    static constexpr bool PERM = true, AFTER_DRAIN = false;
    bf16_t* O;
    __device__ __forceinline__ void operator()(const f32x4 (&acc)[2][2][4][2], const Unit& u, int wr, int wc, int fr, int fq) const {
        const int row0 = u.pm * BM + wr * 64 + fr, col0 = u.pn * 128 + wc * 32 + 8 * fq;
#pragma unroll
        for (int ai = 0; ai < 2; ++ai)
#pragma unroll
            for (int m = 0; m < 4; ++m) {
                f32x4 v0, v1;
#pragma unroll
                for (int j = 0; j < 4; ++j) { v0[j] = silu_f(acc[ai][0][m][0][j]) * acc[ai][1][m][0][j]; v1[j] = silu_f(acc[ai][0][m][1][j]) * acc[ai][1][m][1][j]; }
                *(u32x4*)((unsigned char*)O + act_off(row0 + ai * HALF + m * 16, DFF * 2, 0) + (size_t)col0 * 2) = pack8(v0, v1);
            }
    }
};
struct EpiOutSsq {
    static constexpr bool PERM = true, AFTER_DRAIN = false;
    bf16_t* O; float* ssq;
    __device__ __forceinline__ void operator()(const f32x4 (&acc)[2][2][4][2], const Unit& u, int wr, int wc, int fr, int fq) const {
        const int row0 = u.pm * BM + wr * 64 + fr, col0 = u.pn * BM + wc * 32 + 8 * fq;
#pragma unroll
        for (int ai = 0; ai < 2; ++ai)
#pragma unroll
            for (int m = 0; m < 4; ++m) {
                const int row = row0 + ai * HALF + m * 16; float s = 0.f;
#pragma unroll
                for (int bj = 0; bj < 2; ++bj) { const f32x4 v0 = acc[ai][bj][m][0], v1 = acc[ai][bj][m][1];
                    s += (v0[0] * v0[0] + v0[1] * v0[1]) + (v0[2] * v0[2] + v0[3] * v0[3]) + (v1[0] * v1[0] + v1[1] * v1[1]) + (v1[2] * v1[2] + v1[3] * v1[3]);
                    *(u32x4*)(O + (size_t)row * D + col0 + bj * HALF) = pack8(v0, v1); }
                s += __shfl_xor(s, 16); s += __shfl_xor(s, 32);
                if (fq == 0) ssq[(size_t)row * 16 + u.pn * 4 + wc] = s;
            }
    }
};
template <int GELU> struct EpiSplit {
    static constexpr bool PERM = true, AFTER_DRAIN = false;
    bf16_t* O0; bf16_t* O1; int half; float* vstat;
    __device__ __forceinline__ void operator()(const f32x4 (&acc)[2][2][4][2], const Unit& u, int wr, int wc, int fr, int fq) const {
        int colt = u.pn * BM; const bool second = colt >= half; if (second) colt -= half; const size_t sub = second ? (size_t)4096 * half * 2 : 0;
        const int row0 = u.pm * BM + wr * 64 + fr, col0 = colt + wc * 32 + 8 * fq; const int vt = colt >> 8;
#pragma unroll
        for (int ai = 0; ai < 2; ++ai)
#pragma unroll
            for (int m = 0; m < 4; ++m) {
                const int row = row0 + ai * HALF + m * 16; float s = 0.f, q = 0.f;
#pragma unroll
                for (int bj = 0; bj < 2; ++bj) { f32x4 v0 = acc[ai][bj][m][0], v1 = acc[ai][bj][m][1];
                    if (GELU) {
#pragma unroll
                        for (int j = 0; j < 4; ++j) { v0[j] = gelu_t(v0[j]); v1[j] = gelu_t(v1[j]); }
                        s += (v0[0] + v0[1]) + (v0[2] + v0[3]) + (v1[0] + v1[1]) + (v1[2] + v1[3]);
                        q += (v0[0] * v0[0] + v0[1] * v0[1]) + (v0[2] * v0[2] + v0[3] * v0[3]) + (v1[0] * v1[0] + v1[1] * v1[1]) + (v1[2] * v1[2] + v1[3] * v1[3]); }
                    *(u32x4*)((unsigned char*)O0 + act_off(row, half * 2, sub) + (size_t)(col0 + bj * HALF) * 2) = pack8(v0, v1); }
                if (GELU) { s += __shfl_xor(s, 16); s += __shfl_xor(s, 32); q += __shfl_xor(q, 16); q += __shfl_xor(q, 32);
                    if (second && fq == 0) { float* p = vstat + ((size_t)row * 32 + vt * 4 + wc) * 2; p[0] = s; p[1] = q; } }
            }
    }
};

__device__ __forceinline__ void prep_phase(const Args& a, LAS unsigned char* lds) {
    int tid_ = threadIdx.x; asm volatile("" : "+v"(tid_)); const int tid = tid_, wid = tid >> 6, lane = tid & 63;
    float* MOD = (float*)(a.ws + OFF_MOD);
    {
        LAS float* sc = (LAS float*)lds;
        LAS float* red = sc + 2048;
        for (int i = tid; i < 2048; i += 512) sc[i] = silu_f(a.c[i]);
        __syncthreads();
        for (int it = blockIdx.x; it < 576; it += gridDim.x) {
            const int l = it / 144, nb = it % 144;
            const float* w = a.ada_w + ((size_t)l * 1024 + wid * 128) * NMOD + nb * 64 + lane;
            float a0 = 0.f, a1 = 0.f;
#pragma unroll 16
            for (int k = 0; k < 128; ++k) { const float wv = w[(size_t)k * NMOD]; a0 += sc[wid * 128 + k] * wv; a1 += sc[1024 + wid * 128 + k] * wv; }
            red[(wid * 64 + lane) * 2] = a0; red[(wid * 64 + lane) * 2 + 1] = a1;
            __syncthreads();
            if (tid < 128) { const int ln = tid & 63, b = tid >> 6; float s = 0.f;
#pragma unroll
                for (int w2 = 0; w2 < 8; ++w2) s += red[(w2 * 64 + ln) * 2 + b];
                MOD[(size_t)(l * 2 + b) * NMOD + nb * 64 + ln] = s + a.ada_b[(size_t)l * NMOD + nb * 64 + ln]; }
            __syncthreads();
        }
    }
    {
        LAS float* L = (LAS float*)lds;
        const bool bal = (gridDim.x == 256);
        const int tbeg = bal ? ((int)blockIdx.x < 64 ? (int)blockIdx.x * 18 : 1152 + ((int)blockIdx.x - 64) * 22) : (int)blockIdx.x;
        const int tend = bal ? tbeg + ((int)blockIdx.x < 64 ? 18 : 22) : 5376, tinc = bal ? 1 : (int)gridDim.x;
#define PREP_DECODE(tix_) \
            int t = (tix_), K, N, mode = 0; const float* src; bf16_t* dst; \
            if (t < 2816) { const int mi = t / 352; t %= 352; src = a.ffn_w_in + (size_t)mi * 1024 * 5632; dst = (bf16_t*)(a.ws + OFF_WFI) + (size_t)mi * 5632 * 1024; K = 1024; N = 5632; mode = 1; } \
            else if ((t -= 2816) < 1408) { const int mi = t / 176; t %= 176; src = a.ffn_w_out + (size_t)mi * 2816 * 1024; dst = (bf16_t*)(a.ws + OFF_WFO) + (size_t)mi * 1024 * 2816; K = 2816; N = 1024; } \
            else if ((t -= 1408) < 256) { const int mi = t / 128; t %= 128; src = a.rg_w_in + (size_t)mi * 1024 * 2048; dst = (bf16_t*)(a.ws + OFF_WRI) + (size_t)mi * 2048 * 1024; K = 1024; N = 2048; } \
            else if ((t -= 256) < 128) { const int mi = t / 64; t %= 64; src = a.rg_w_out + (size_t)mi * 1024 * 1024; dst = (bf16_t*)(a.ws + OFF_WRO) + (size_t)mi * 1024 * 1024; K = 1024; N = 1024; } \
            else if ((t -= 128) < 512) { const int mi = t / 256; t %= 256; src = a.gm_w_in + (size_t)mi * 1024 * 4096; dst = (bf16_t*)(a.ws + OFF_WGI) + (size_t)mi * 4096 * 1024; K = 1024; N = 4096; } \
            else { t -= 512; const int mi = t / 128; t %= 128; src = a.gm_w_out + (size_t)mi * 2048 * 1024; dst = (bf16_t*)(a.ws + OFF_WGO) + (size_t)mi * 1024 * 2048; K = 2048; N = 1024; } \
            const int ntn = N >> 8, kt = t / ntn, nt = t % ntn, k0 = kt * 64, n0 = nt * 256;
#define PREP_LOAD() _Pragma("unroll") for (int i = 0; i < 8; ++i) { const int idx = tid + 512 * i, row = idx >> 6, c4 = idx & 63; v[i] = *(const f32x4*)(src + (size_t)(k0 + row) * N + n0 + c4 * 4); }
        f32x4 v[8];
        if (tbeg < tend) { PREP_DECODE(tbeg) PREP_LOAD() (void)dst; (void)K; (void)mode; }
        for (int tix = tbeg; tix < tend; tix += tinc) {
#pragma unroll
            for (int i = 0; i < 8; ++i) { const int idx = tid + 512 * i, row = idx >> 6, c4 = idx & 63; *(LAS f32x4*)(L + row * 260 + c4 * 4) = v[i]; }
            if (tix + tinc < tend) { PREP_DECODE(tix + tinc) PREP_LOAD() (void)dst; (void)K; (void)mode; }
            __syncthreads();
            PREP_DECODE(tix)
            (void)src; (void)ntn; (void)kt; (void)nt;
            const int n = tid & 255, kh = tid >> 8, c = n0 + n; int drow = c;
            if (mode == 1) { const int up = c >= 2816, cc = up ? c - 2816 : c; drow = (cc >> 7) * 256 + up * 128 + (cc & 127); }
            bf16_t* dp = dst + (size_t)drow * K + k0 + kh * 32;
#pragma unroll
            for (int p = 0; p < 4; ++p) { f32x4 f0, f1;
#pragma unroll
                for (int j = 0; j < 4; ++j) { f0[j] = L[(kh * 32 + p * 8 + j) * 260 + n]; f1[j] = L[(kh * 32 + p * 8 + 4 + j) * 260 + n]; }
                *(u32x4*)(dp + p * 8) = pack8(f0, f1); }
            __syncthreads();
        }
#undef PREP_DECODE
#undef PREP_LOAD
    }
    {
        bf16_t* WRG = (bf16_t*)(a.ws + OFF_WRG);
        for (int idx = blockIdx.x * 512 + tid; idx < 524288; idx += gridDim.x * 512) {
            const int d = idx & 127, e = (idx >> 7) & 127, which = (idx >> 14) & 1, h = (idx >> 15) & 7, k2 = idx >> 18;
            const float* s = (which ? a.rg_w_x : a.rg_w_a) + (((size_t)(k2 * 8 + h) * 128 + d) * 128 + e);
            WRG[idx] = f2bf(*s);
        }
    }
    {
        float* NSP = (float*)(a.ws + OFF_NSP);
        for (int i = blockIdx.x * 512 + tid; i < 2048; i += gridDim.x * 512) NSP[i] = -8.0f * log1pf(expf(-a.rg_lambda[i])) * 1.4426950408889634f;
    }
    {
        bf16_t* WGS = (bf16_t*)(a.ws + OFF_WGS); float* C2 = (float*)(a.ws + OFF_C2);
        for (int row = blockIdx.x * 8 + wid; row < 2048; row += gridDim.x * 8) {
            const int t = row & 127; float sum = 0.f;
#pragma unroll
            for (int s = lane; s < 128; s += 64) { float w = a.gm_w_s[(size_t)row * 128 + s]; if (s > t) w = 0.f; WGS[(size_t)row * 128 + s] = f2bf(w); sum += w; }
#pragma unroll
            for (int o = 32; o >= 1; o >>= 1) sum += __shfl_xor(sum, o);
            if (lane == 0) C2[row] = sum;
        }
    }
}

__device__ __forceinline__ void ew_phase(const Args& a, int vb, int sp, int sn, int wm, const float* xin, float* xout, bf16_t* H) {
    int tid_ = threadIdx.x; asm volatile("" : "+v"(tid_)); const int tid = tid_, wid = tid >> 6, lane = tid & 63;
    const float* MOD = (const float*)(a.ws + OFF_MOD);
    const float* SSQc = (const float*)(a.ws + ((sp & 1) ? OFF_SSQ2 : OFF_SSQ)); const bf16_t* Oc = (const bf16_t*)(a.ws + ((sp & 1) ? OFF_O2 : OFF_O));
    const float* SSQp = (const float*)(a.ws + OFF_SSQ); const bf16_t* Op = (const bf16_t*)(a.ws + OFF_O);
    for (int rb = vb * 8 + wid; rb < T / 16; rb += gridDim.x * 8) {
        const int row0 = rb * 16, b = row0 >> 14;
        f32x4 pg[4], pgp[4], ps[4], pb[4];
#pragma unroll
        for (int k = 0; k < 4; ++k) { pg[k] = (f32x4){0.f, 0.f, 0.f, 0.f}; pgp[k] = pg[k]; ps[k] = pg[k]; pb[k] = pg[k]; }
        if (sp >= 0) { const int l = sp / 3, j = sp % 3; const float resw = (j == 1) ? 1.0f : 0.5f;
            const float* gate = MOD + (size_t)(l * 2 + b) * NMOD + j * 3072 + 2048 + 4 * lane; const float* gp = a.norm_post + (size_t)(l * 3 + j) * D + 4 * lane;
#pragma unroll
            for (int k = 0; k < 4; ++k) pg[k] = resw * (*(const f32x4*)(gate + 256 * k)) * (*(const f32x4*)(gp + 256 * k)); }
        if (wm == 2) { const int s2 = sp - 1, l = s2 / 3, j = s2 % 3; const float resw = (j == 1) ? 1.0f : 0.5f;
            const float* gate = MOD + (size_t)(l * 2 + b) * NMOD + j * 3072 + 2048 + 4 * lane; const float* gp = a.norm_post + (size_t)(l * 3 + j) * D + 4 * lane;
#pragma unroll
            for (int k = 0; k < 4; ++k) pgp[k] = resw * (*(const f32x4*)(gate + 256 * k)) * (*(const f32x4*)(gp + 256 * k)); }
        if (sn >= 0) { const int l = sn / 3, j = sn % 3;
            const float* shift = MOD + (size_t)(l * 2 + b) * NMOD + j * 3072 + 4 * lane; const float* gpre = a.norm_pre + (size_t)(l * 3 + j) * D + 4 * lane;
#pragma unroll
            for (int k = 0; k < 4; ++k) { ps[k] = (*(const f32x4*)(gpre + 256 * k)) * (1.0f + *(const f32x4*)(shift + 1024 + 256 * k)); pb[k] = *(const f32x4*)(shift + 256 * k); } }
        f32x4 xn[4]; u32x2 on[4], opn[4]; float sn_ = 0.f, spn_ = 0.f;
#pragma unroll
        for (int k = 0; k < 4; ++k) { on[k] = (u32x2){0u, 0u}; opn[k] = on[k]; }
#define EW_LOADROW(rowi) do { const size_t ro_ = (size_t)(rowi) * D + 4 * lane; \
            _Pragma("unroll") for (int k = 0; k < 4; ++k) xn[k] = __builtin_nontemporal_load((const f32x4*)(xin + ro_ + 256 * k)); \
            if (sp >= 0) { sn_ = SSQc[(size_t)(rowi) * 16 + (lane & 15)]; \
                _Pragma("unroll") for (int k = 0; k < 4; ++k) on[k] = *(const u32x2*)(Oc + ro_ + 256 * k); } \
            if (wm == 2) { spn_ = SSQp[(size_t)(rowi) * 16 + (lane & 15)]; \
                _Pragma("unroll") for (int k = 0; k < 4; ++k) opn[k] = *(const u32x2*)(Op + ro_ + 256 * k); } } while (0)
        EW_LOADROW(row0);
        for (int rr = 0; rr < 16; ++rr) {
            const size_t ro = (size_t)(row0 + rr) * D + 4 * lane;
            f32x4 x[4]; u32x2 oc[4], opc[4]; float s = sn_, s2 = spn_;
#pragma unroll
            for (int k = 0; k < 4; ++k) { x[k] = xn[k]; oc[k] = on[k]; opc[k] = opn[k]; }
            if (rr < 15) EW_LOADROW(row0 + rr + 1);
            if (wm == 2) {
                s2 += __shfl_xor(s2, 1); s2 += __shfl_xor(s2, 2); s2 += __shfl_xor(s2, 4); s2 += __shfl_xor(s2, 8);
                const float rstd2 = rsqrtf(s2 * (1.0f / 1024.0f) + EPS);
#pragma unroll
                for (int k = 0; k < 4; ++k) { const u32x2 ow = opc[k]; const f32x4 o = (f32x4){bf_lo(ow.x), bf_hi(ow.x), bf_lo(ow.y), bf_hi(ow.y)}; x[k] += pgp[k] * (o * rstd2); }
            }
            if (sp >= 0) {
                s += __shfl_xor(s, 1); s += __shfl_xor(s, 2); s += __shfl_xor(s, 4); s += __shfl_xor(s, 8);
                const float rstd = rsqrtf(s * (1.0f / 1024.0f) + EPS);
#pragma unroll
                for (int k = 0; k < 4; ++k) { const u32x2 ow = oc[k]; const f32x4 o = (f32x4){bf_lo(ow.x), bf_hi(ow.x), bf_lo(ow.y), bf_hi(ow.y)};
                    x[k] += pg[k] * (o * rstd); if (wm == 2) __builtin_nontemporal_store(x[k], (f32x4*)(xout + ro + 256 * k)); }
            }
            if (sn >= 0) {
                float ss = 0.f;
#pragma unroll
                for (int k = 0; k < 4; ++k) ss += (x[k][0] * x[k][0] + x[k][1] * x[k][1]) + (x[k][2] * x[k][2] + x[k][3] * x[k][3]);
#pragma unroll
                for (int o = 32; o >= 1; o >>= 1) ss += __shfl_xor(ss, o);
                const float rs = rsqrtf(ss * (1.0f / 1024.0f) + EPS);
#pragma unroll
                for (int k = 0; k < 4; ++k) { const f32x4 hv = (x[k] * rs) * ps[k] + pb[k]; u32x2 w; w.x = cvt_pk_bf16(hv[0], hv[1]); w.y = cvt_pk_bf16(hv[2], hv[3]); *(u32x2*)(H + ro + 256 * k) = w; }
            }
        }
#undef EW_LOADROW
    }
}

__device__ __forceinline__ void rg_scan_phase(const Args& a, int vb, int k2, LAS unsigned char* lds) {
    int tid_ = threadIdx.x; asm volatile("" : "+v"(tid_)); const int tid = tid_, wid = tid >> 6, lane = tid & 63, fr = lane & 15, fq = lane >> 4;
    LAS float* XC = (LAS float*)lds; LAS float* SA = XC + 128 * 132; LAS float* SEG = SA + 128 * 132;
    unsigned char* AB = a.ws + OFF_ACT;
    float* CHA = (float*)(a.ws + OFF_CHA); float* CHH = (float*)(a.ws + OFF_CHH);
    const float* cw = a.rg_conv_w + (size_t)k2 * 4 * D; const float* cb = a.rg_conv_b + (size_t)k2 * D;
    for (int ch = vb; ch < 256; ch += gridDim.x) {
      const int t0 = ch * 128; const bool first = (t0 & (SEQ - 1)) == 0;
      u32x4 xq[7];
#define RG_PF_CONV(hh) do { const int c0_ = (hh) * 128 + (tid & 15) * 8; \
        _Pragma("unroll") for (int r = 0; r < 7; ++r) { const int tt = 4 * (tid >> 4) - 3 + r; \
            if (tt < 0 && first) xq[r] = (u32x4){0u, 0u, 0u, 0u}; else xq[r] = *(const u32x4*)(AB + act_off(t0 + tt, 2048, 0) + (size_t)c0_ * 2); } } while (0)
      RG_PF_CONV(0);
#pragma unroll 1
      for (int h = 0; h < 8; ++h) {
        {
            const int cg8 = tid & 15, tq = tid >> 4, c0 = h * 128 + cg8 * 8;
            float w[4][8], bias[8], xr[7][8];
#pragma unroll
            for (int k = 0; k < 4; ++k) { const f32x4 w0 = *(const f32x4*)(cw + k * D + c0), w1 = *(const f32x4*)(cw + k * D + c0 + 4);
#pragma unroll
                for (int j = 0; j < 4; ++j) { w[k][j] = w0[j]; w[k][4 + j] = w1[j]; } }
            { const f32x4 b0 = *(const f32x4*)(cb + c0), b1 = *(const f32x4*)(cb + c0 + 4);
#pragma unroll
                for (int j = 0; j < 4; ++j) { bias[j] = b0[j]; bias[4 + j] = b1[j]; } }
#pragma unroll
            for (int r = 0; r < 7; ++r) unpack8(xq[r], xr[r]);
#pragma unroll
            for (int q = 0; q < 4; ++q) { f32x4 o0, o1;
#pragma unroll
                for (int j = 0; j < 4; ++j) {
                    o0[j] = bias[j] + w[0][j] * xr[q][j] + w[1][j] * xr[q + 1][j] + w[2][j] * xr[q + 2][j] + w[3][j] * xr[q + 3][j];
                    o1[j] = bias[4 + j] + w[0][4 + j] * xr[q][4 + j] + w[1][4 + j] * xr[q + 1][4 + j] + w[2][4 + j] * xr[q + 2][4 + j] + w[3][4 + j] * xr[q + 3][4 + j]; }
                *(LAS f32x4*)(XC + (4 * tq + q) * 132 + cg8 * 8) = o0; *(LAS f32x4*)(XC + (4 * tq + q) * 132 + cg8 * 8 + 4) = o1; }
        }
        __syncthreads();
        f32x4 bval[8];
        const int cl = 16 * wid + 4 * fq;
        {
            const bf16_t* Wg = (const bf16_t*)(a.ws + OFF_WRG) + (size_t)(k2 * 8 + h) * 256 * 128;
            bf16x8 bfr[2][4];
#pragma unroll
            for (int wh = 0; wh < 2; ++wh)
#pragma unroll
                for (int ks = 0; ks < 4; ++ks) bfr[wh][ks] = *(const bf16x8*)(Wg + (size_t)(wh * 128 + 16 * wid + fr) * 128 + 32 * ks + 8 * fq);
            const int c = k2 * D + h * 128 + cl;
            const f32x4 ba = *(const f32x4*)(a.rg_b_a + c) * -1.4426950408889634f, bx = *(const f32x4*)(a.rg_b_x + c) * -1.4426950408889634f, nsp = *(const f32x4*)((const float*)(a.ws + OFF_NSP) + c);
#pragma unroll
            for (int mb = 0; mb < 8; ++mb) {
                f32x4 accR = (f32x4){0.f, 0.f, 0.f, 0.f}, accI = accR;
                {
                    const LAS float* p = XC + (16 * mb + fr) * 132 + 8 * fq; f32x4 v[8];
                    asm volatile("ds_read_b128 %0, %8\n\tds_read_b128 %1, %8 offset:16\n\tds_read_b128 %2, %8 offset:128\n\tds_read_b128 %3, %8 offset:144\n\t"
                                 "ds_read_b128 %4, %8 offset:256\n\tds_read_b128 %5, %8 offset:272\n\tds_read_b128 %6, %8 offset:384\n\tds_read_b128 %7, %8 offset:400\n\ts_waitcnt lgkmcnt(0)"
                                 : "=&v"(v[0]), "=&v"(v[1]), "=&v"(v[2]), "=&v"(v[3]), "=&v"(v[4]), "=&v"(v[5]), "=&v"(v[6]), "=&v"(v[7]) : "v"(p) : "memory");
#pragma unroll
                    for (int ks = 0; ks < 4; ++ks) { const u32x4 pk = pack8(v[2 * ks], v[2 * ks + 1]); const bf16x8 af = __builtin_bit_cast(bf16x8, pk);
                        accR = __builtin_amdgcn_mfma_f32_16x16x32_bf16(bfr[0][ks], af, accR, 0, 0, 0); accI = __builtin_amdgcn_mfma_f32_16x16x32_bf16(bfr[1][ks], af, accI, 0, 0, 0); } }
                const int t = 16 * mb + fr; const f32x4 xc = *(const LAS f32x4*)(XC + t * 132 + cl); f32x4 av;
#pragma unroll
                for (int j = 0; j < 4; ++j) {
                    const float er = __builtin_amdgcn_exp2f(fminf(fmaf(accR[j], -1.4426950408889634f, ba[j]), 57.7f)), ei = __builtin_amdgcn_exp2f(fminf(fmaf(accI[j], -1.4426950408889634f, bx[j]), 57.7f));
                    const float dr = 1.0f + er, di = 1.0f + ei, q = __builtin_amdgcn_rcpf(dr * di);
                    const float r = q * di, ig = q * dr, la = nsp[j] * r;
                    const float aa = __builtin_amdgcn_exp2f(la); av[j] = aa; bval[mb][j] = __builtin_amdgcn_sqrtf(fmaxf(1.0f - aa * aa, 0.f)) * (ig * xc[j]); }
                *(LAS f32x4*)(SA + t * 132 + cl) = av;
            }
        }
        __syncthreads();
#pragma unroll
        for (int mb = 0; mb < 8; ++mb) *(LAS f32x4*)(XC + (16 * mb + fr) * 132 + cl) = bval[mb];
        __syncthreads();
        if (h < 7) RG_PF_CONV(h + 1);
        {
            const int c = tid & 127, sg = tid >> 7;
            float P = 1.f, Hh = 0.f;
#pragma unroll 1
            for (int ib = 0; ib < 4; ++ib) {
                float av[8], bv[8];
#pragma unroll
                for (int i = 0; i < 8; ++i) { const int t = 32 * sg + 8 * ib + i; av[i] = SA[t * 132 + c]; bv[i] = XC[t * 132 + c]; }
#pragma unroll
                for (int i = 0; i < 8; ++i) { Hh = av[i] * Hh + bv[i]; P *= av[i]; bv[i] = Hh; av[i] = P; }
#pragma unroll
                for (int i = 0; i < 8; ++i) { const int t = 32 * sg + 8 * ib + i; XC[t * 132 + c] = bv[i]; SA[t * 132 + c] = av[i]; }
            }
            SEG[(sg * 128 + c) * 2] = P; SEG[(sg * 128 + c) * 2 + 1] = Hh;
        }
        __syncthreads();
        {
            const int cg8 = tid & 15, tq = tid >> 4;
            float Ain[8], Hin[8];
#pragma unroll
            for (int j = 0; j < 8; ++j) { Ain[j] = 1.f; Hin[j] = 0.f; }
#pragma unroll
            for (int i = 0; i < 4; ++i) { const int t = tq + 32 * i; const size_t cb2 = (size_t)(h * 128 + cg8 * 8) * 2;
                const LAS float* p = XC + t * 132 + cg8 * 8; const LAS float* q = SA + t * 132 + cg8 * 8;
                const f32x4 h0 = *(const LAS f32x4*)p, h1 = *(const LAS f32x4*)(p + 4), p0 = *(const LAS f32x4*)q, p1 = *(const LAS f32x4*)(q + 4);
                f32x4 ho0, ho1, po0, po1;
#pragma unroll
                for (int j = 0; j < 4; ++j) { ho0[j] = h0[j] + p0[j] * Hin[j]; po0[j] = p0[j] * Ain[j]; ho1[j] = h1[j] + p1[j] * Hin[4 + j]; po1[j] = p1[j] * Ain[4 + j]; }
                *(u32x4*)(AB + act_off(t0 + t, 2048, (size_t)16 << 20) + cb2) = pack8(ho0, ho1);
                *(u32x4*)(AB + act_off(t0 + t, 2048, (size_t)24 << 20) + cb2) = pack8(po0, po1);
#pragma unroll
                for (int j2 = 0; j2 < 4; ++j2) { const f32x4 sv = *(const LAS f32x4*)(SEG + (i * 128 + cg8 * 8 + 2 * j2) * 2);
                    Hin[2 * j2] = sv[0] * Hin[2 * j2] + sv[1]; Ain[2 * j2] *= sv[0]; Hin[2 * j2 + 1] = sv[2] * Hin[2 * j2 + 1] + sv[3]; Ain[2 * j2 + 1] *= sv[2]; } }
            if (tq == 0) {
#pragma unroll
                for (int j = 0; j < 8; ++j) { CHA[(size_t)ch * D + h * 128 + cg8 * 8 + j] = Ain[j]; CHH[(size_t)ch * D + h * 128 + cg8 * 8 + j] = Hin[j]; } }
        }
        __syncthreads();
      }
#undef RG_PF_CONV
    }
}

__device__ __forceinline__ void rg_out_phase(const Args& a, int vb, LAS unsigned char* lds) {
    int tid_ = threadIdx.x; asm volatile("" : "+v"(tid_)); const int tid = tid_;
    LAS float* CAR = (LAS float*)lds;
    unsigned char* AB = a.ws + OFF_ACT;
    const float* CHA = (const float*)(a.ws + OFF_CHA); const float* CHH = (const float*)(a.ws + OFF_CHH);
    for (int ch = vb; ch < 256; ch += gridDim.x) {
        const int firstc = ch & ~127, t0 = ch * 128;
        {
            const int q = tid & 255, hv = tid >> 8, n = ch - firstc, nlo = n >> 1, jb = firstc + (hv ? nlo : 0), je = hv ? ch : firstc + nlo;
            f32x4 Aa = (f32x4){1.f, 1.f, 1.f, 1.f}, Hh = (f32x4){0.f, 0.f, 0.f, 0.f};
#pragma unroll 8
            for (int j = jb; j < je; ++j) { const f32x4 av = *(const f32x4*)(CHA + (size_t)j * D + 4 * q), hv4 = *(const f32x4*)(CHH + (size_t)j * D + 4 * q); Hh = av * Hh + hv4; Aa = Aa * av; }
            LAS f32x4* TMP = (LAS f32x4*)(CAR + 1024);
            if (hv) { TMP[q * 2] = Aa; TMP[q * 2 + 1] = Hh; }
            __syncthreads();
            if (!hv) { const f32x4 A2 = TMP[q * 2], H2 = TMP[q * 2 + 1]; *(LAS f32x4*)(CAR + 4 * q) = A2 * Hh + H2; }
        }
        __syncthreads();
        const int cg8 = tid & 127; const f32x4 ca = *(const LAS f32x4*)(CAR + cg8 * 8), cb = *(const LAS f32x4*)(CAR + cg8 * 8 + 4);
        const float car[8] = {ca[0], ca[1], ca[2], ca[3], cb[0], cb[1], cb[2], cb[3]};
        const size_t cb2 = (size_t)cg8 * 16;
#pragma unroll 1
        for (int ib = 0; ib < 8; ++ib) {
            u32x4 qh[4], qa[4], qg[4];
#pragma unroll
            for (int k = 0; k < 4; ++k) { const int t = (tid >> 7) + 4 * (4 * ib + k);
                qh[k] = *(const u32x4*)(AB + act_off(t0 + t, 2048, (size_t)16 << 20) + cb2); qa[k] = *(const u32x4*)(AB + act_off(t0 + t, 2048, (size_t)24 << 20) + cb2);
                qg[k] = *(const u32x4*)(AB + act_off(t0 + t, 2048, (size_t)8 << 20) + cb2); }
#pragma unroll
            for (int k = 0; k < 4; ++k) { const int t = (tid >> 7) + 4 * (4 * ib + k);
                float hl[8], ap[8], gb[8]; unpack8(qh[k], hl); unpack8(qa[k], ap); unpack8(qg[k], gb);
                f32x4 y0, y1;
#pragma unroll
                for (int j = 0; j < 4; ++j) { y0[j] = (hl[j] + ap[j] * car[j]) * gelu_t(gb[j]); y1[j] = (hl[4 + j] + ap[4 + j] * car[4 + j]) * gelu_t(gb[4 + j]); }
                *(u32x4*)(AB + act_off(t0 + t, 2048, (size_t)8 << 20) + cb2) = pack8(y0, y1); }
        }
        __syncthreads();
    }
}

__device__ __forceinline__ void gm_gate_phase(const Args& a, int vb, int k2, LAS unsigned char* lds) {
    int tid_ = threadIdx.x; asm volatile("" : "+v"(tid_)); const int tid = tid_, wid = tid >> 6, lane = tid & 63, fr = lane & 15, fq = lane >> 4;
    constexpr int VS = 272, AS = 136;
    LAS bf16_t* VT = (LAS bf16_t*)lds;
    LAS bf16_t* AW = VT + 128 * VS;
    LAS float* MU = (LAS float*)(AW + 128 * AS); LAS float* RSTD = MU + 128; LAS float* C1 = RSTD + 128; LAS float* C2S = C1 + 128; LAS float* BSS = C2S + 128;
    unsigned char* AB = a.ws + OFF_ACT;
    const float* VSTAT = (const float*)(a.ws + OFF_VSTAT); const float* C2 = (const float*)(a.ws + OFF_C2);
    const bf16_t* WGS = (const bf16_t*)(a.ws + OFF_WGS);
    for (int ch = vb; ch < 256; ch += gridDim.x) {
        const int t0 = ch * 128;
        u32x4 vq[8], wq4[4];
        { const bf16_t* wp0 = WGS + ((size_t)(k2 * 8 + 0) * 128 + (tid >> 2)) * 128 + 32 * (tid & 3);
#pragma unroll
          for (int p = 0; p < 4; ++p) wq4[p] = *(const u32x4*)(wp0 + 8 * p); }
#pragma unroll
        for (int i = 0; i < 8; ++i) { const int item = tid + 512 * i, row = item >> 5, c16 = item & 31; vq[i] = *(const u32x4*)(AB + act_off(t0 + row, 4096, (size_t)16 << 20) + (size_t)c16 * 16); }
        if (tid < 128) { const float* p = VSTAT + (size_t)(t0 + tid) * 64; float s = 0.f, q = 0.f;
#pragma unroll
            for (int i = 0; i < 16; ++i) { const f32x4 v = *(const f32x4*)(p + 4 * i); s += v[0] + v[2]; q += v[1] + v[3]; }
            const float mu = s * (1.0f / 2048.0f), var = fmaxf(q * (1.0f / 2048.0f) - mu * mu, 0.f); MU[tid] = mu; RSTD[tid] = rsqrtf(var + EPS); }
        __syncthreads();
        for (int g = 0; g < 8; ++g) {
            const int d0 = g * 256 + 32 * wid + 8 * fq;
            u32x4 uq[8];
#pragma unroll
            for (int mb = 0; mb < 8; ++mb)
                uq[mb] = *(const u32x4*)(AB + act_off(t0 + 16 * mb + fr, 4096, 0) + (size_t)d0 * 2);
            {
                const int t = tid >> 2, sq = tid & 3; float c1 = 0.f;
                if (tid < 128) { C2S[tid] = C2[(k2 * 8 + g) * 128 + tid]; BSS[tid] = a.gm_b_s[(size_t)(k2 * 8 + g) * 128 + tid]; }
#pragma unroll
                for (int p = 0; p < 4; ++p) { float f[8]; unpack8(wq4[p], f); f32x4 f0, f1;
#pragma unroll
                    for (int j = 0; j < 4; ++j) { f0[j] = f[j] * RSTD[32 * sq + 8 * p + j]; f1[j] = f[4 + j] * RSTD[32 * sq + 8 * p + 4 + j]; }
                    const u32x4 pk = pack8(f0, f1); float fr8[8]; unpack8(pk, fr8);
#pragma unroll
                    for (int j = 0; j < 8; ++j) c1 += fr8[j] * MU[32 * sq + 8 * p + j];
                    *(LAS u32x4*)(AW + t * AS + 32 * sq + 8 * p) = pk; }
                c1 += __shfl_xor(c1, 1); c1 += __shfl_xor(c1, 2);
                if (sq == 0) C1[t] = c1;
            }
            {
#pragma unroll
                for (int i = 0; i < 8; ++i) { const int item = tid + 512 * i, row = item >> 5, c16 = item & 31; const u32x4 q = vq[i];
                    LAS u32x2* dp = (LAS u32x2*)(VT + row * VS + 8 * c16); dp[0] = (u32x2){q.x, q.y}; dp[1] = (u32x2){q.z, q.w}; }
            }
            __syncthreads();
            if (g < 7) {
                { const bf16_t* wpn = WGS + ((size_t)(k2 * 8 + g + 1) * 128 + (tid >> 2)) * 128 + 32 * (tid & 3);
#pragma unroll
                  for (int p = 0; p < 4; ++p) wq4[p] = *(const u32x4*)(wpn + 8 * p); }
#pragma unroll
                for (int i = 0; i < 8; ++i) { const int item = tid + 512 * i, row = item >> 5, c16 = item & 31; vq[i] = *(const u32x4*)(AB + act_off(t0 + row, 4096, (size_t)16 << 20) + (size_t)((g + 1) * 256 + 8 * c16) * 2); } }
            f32x4 gd[2], bd[2];
#pragma unroll
            for (int nb = 0; nb < 2; ++nb) { gd[nb] = *(const f32x4*)(a.gm_ln_g + (size_t)k2 * 2048 + d0 + 4 * nb); bd[nb] = *(const f32x4*)(a.gm_ln_b + (size_t)k2 * 2048 + d0 + 4 * nb); }
#pragma unroll 1
            for (int hf = 0; hf < 2; ++hf) {
                float c2t[4], bst[4];
#pragma unroll
                for (int ml = 0; ml < 4; ++ml) { const int t = 64 * hf + 16 * ml + fr;
                    c2t[ml] = C2S[t]; bst[ml] = BSS[t];
                }
                f32x4 acc[4][2];
#pragma unroll
                for (int ml = 0; ml < 4; ++ml) { acc[ml][0] = (f32x4){0.f, 0.f, 0.f, 0.f}; acc[ml][1] = acc[ml][0]; }
#pragma unroll 1
                for (int ks = 0; ks < 2 * hf + 2; ++ks) {
                    bf16x8 vf[2];
                    {
                        const LAS bf16_t* vp = VT + (32 * ks + 8 * fq + ((lane & 15) >> 2)) * VS + 32 * wid + 8 * (lane & 3);
                        u32x2 r00, r01, r10, r11;
                        asm volatile("ds_read_b64_tr_b16 %0, %4\n\tds_read_b64_tr_b16 %1, %4 offset:2176\n\tds_read_b64_tr_b16 %2, %4 offset:8\n\tds_read_b64_tr_b16 %3, %4 offset:2184\n\ts_waitcnt lgkmcnt(0)"
                                     : "=&v"(r00), "=&v"(r01), "=&v"(r10), "=&v"(r11) : "v"(vp) : "memory");
                        vf[0] = __builtin_bit_cast(bf16x8, (u32x4){r00.x, r00.y, r01.x, r01.y});
                        vf[1] = __builtin_bit_cast(bf16x8, (u32x4){r10.x, r10.y, r11.x, r11.y}); }
                    bf16x8 af4[4];
                    {   const LAS bf16_t* ap = AW + (64 * hf + fr) * AS + 32 * ks + 8 * fq;
                        asm volatile("ds_read_b128 %0, %4\n\tds_read_b128 %1, %4 offset:4352\n\tds_read_b128 %2, %4 offset:8704\n\tds_read_b128 %3, %4 offset:13056\n\ts_waitcnt lgkmcnt(0)"
                                     : "=&v"(af4[0]), "=&v"(af4[1]), "=&v"(af4[2]), "=&v"(af4[3]) : "v"(ap) : "memory"); }
#pragma unroll
                    for (int ml = 0; ml < 4; ++ml) if (64 * hf + 16 * ml + 15 >= 32 * ks) {
                        acc[ml][0] = __builtin_amdgcn_mfma_f32_16x16x32_bf16(vf[0], af4[ml], acc[ml][0], 0, 0, 0);
                        acc[ml][1] = __builtin_amdgcn_mfma_f32_16x16x32_bf16(vf[1], af4[ml], acc[ml][1], 0, 0, 0); }
                }
#pragma unroll
                for (int ml = 0; ml < 4; ++ml) { const int t = 64 * hf + 16 * ml + fr; const float c1t = C1[t];
                    const u32x4 uw = hf ? uq[4 + ml] : uq[ml];
                    const f32x4 u0 = (f32x4){bf_lo(uw.x), bf_hi(uw.x), bf_lo(uw.y), bf_hi(uw.y)}, u1 = (f32x4){bf_lo(uw.z), bf_hi(uw.z), bf_lo(uw.w), bf_hi(uw.w)};
                    const f32x4 y0 = u0 * (gd[0] * (acc[ml][0] - c1t) + bd[0] * c2t[ml] + bst[ml]), y1 = u1 * (gd[1] * (acc[ml][1] - c1t) + bd[1] * c2t[ml] + bst[ml]);
                    *(u32x4*)(AB + act_off(t0 + t, 4096, 0) + (size_t)d0 * 2) = pack8(y0, y1); }
            }
            __syncthreads();
        }
    }
}

template <class Epi> __device__ __forceinline__ void run_gemm(LAS unsigned char* lds, int c, const bf16_t* A, size_t ars, const bf16_t* Bt, int N, int K, const Epi& E) {
    StaticOrder S; S.init(T, N, (int)gridDim.x, c);
    Gemm g; g.A = A; g.Bt = Bt; g.M = T; g.N = N; g.K = K; g.ars = ars;
    gemm_phase<Epi, StaticOrder, false>(lds, g, S, E, nullptr);
}

__global__ void __launch_bounds__(512) fwd_megakernel(Args a) {
    extern __shared__ __attribute__((aligned(16))) unsigned char shm[];
    LAS unsigned char* lds = (LAS unsigned char*)shm;
    cg::grid_group grid = cg::this_grid();
#ifdef TPROBE
    const unsigned long long tkstart = __builtin_amdgcn_s_memrealtime();
#endif
    volatile LAS unsigned* xst = (volatile LAS unsigned*)(lds + LDS_BYTES - 16);
    unsigned* LOC = (unsigned*)(a.ws + OFF_LOC);
    const unsigned myx = xb_xcc_id() & 7u;
    if (threadIdx.x == 0) { xst[0] = 0u; xst[1] = 0u; xst[2] = xb_add(LOC + 64 * myx, 1u); }
    __syncthreads();
    const XcdBarrier xb = xcd_barrier_post((unsigned*)(a.ws + OFF_BAR), xst);
    const unsigned myr = xst[2];
    bf16_t* H = (bf16_t*)(a.ws + OFF_H); bf16_t* O = (bf16_t*)(a.ws + OFF_O); bf16_t* ACT = (bf16_t*)(a.ws + OFF_ACT);
    float* SSQ = (float*)(a.ws + OFF_SSQ);

    prep_phase(a, lds);
    if (a.ws == nullptr) grid.sync();
    xcd_barrier(xb);
#ifdef FORCE_FALLBACK
    bool okl = false;
#else
    bool okl = (gridDim.x == 256);
#endif
#pragma unroll
    for (int x = 0; x < 8; ++x) okl = okl && (xb_ld(LOC + 64 * x) == 32u);
    const int vb = okl ? (int)(myx * 32u + myr) : (int)blockIdx.x;
    const int cg_ = okl ? (int)(myr * 8u + myx) : (int)blockIdx.x;
    unsigned* lcnt = LOC + 64 * (8 + myx);
#ifdef TPROBE
    unsigned long long tacc = 0ull, tprev = __builtin_amdgcn_s_memrealtime(); int tcur = 1; if (TPROBE == 3) tacc = tprev - tkstart;
#define TCAT(c) tcur = (c)
#define TSTAMP() do { const unsigned long long t_ = __builtin_amdgcn_s_memrealtime(); if (tcur == TPROBE) tacc += t_ - tprev; tprev = t_; } while (0)
#define GSYNC() do { xcd_barrier(xb); TSTAMP(); } while (0)
#else
#define TCAT(c)
#define TSTAMP()
#define GSYNC() xcd_barrier(xb)
#endif
#define LSYNC() do { if (okl) xcc_local_barrier(lcnt, 32u); else xcd_barrier(xb); TSTAMP(); } while (0)
    const size_t ARS_H = (size_t)4096 * D * 2;

    TCAT(1); ew_phase(a, vb, -1, 0, 0, a.x, a.out, H);
    LSYNC();
    for (int si = 0; si < 12; ++si) {
        const int l = si / 3, j = si % 3, k2 = l >> 1;
        const int type = (j != 1) ? 0 : ((l & 1) ? 2 : 1);
        const bf16_t* A2; const bf16_t* B2; int K2;
        if (type == 0) {
            const int fi = l * 2 + (j >> 1);
            EpiSwiglu e; e.O = ACT; TCAT(0);
            run_gemm(lds, cg_, H, ARS_H, (const bf16_t*)(a.ws + OFF_WFI) + (size_t)fi * 5632 * 1024, 5632, 1024, e);
            A2 = ACT; B2 = (const bf16_t*)(a.ws + OFF_WFO) + (size_t)fi * 1024 * 2816; K2 = 2816;
            LSYNC();
        } else if (type == 1) {
            TCAT(0); EpiSplit<0> e; e.O0 = ACT; e.O1 = nullptr; e.half = 1024; e.vstat = nullptr;
            run_gemm(lds, cg_, H, ARS_H, (const bf16_t*)(a.ws + OFF_WRI) + (size_t)k2 * 2048 * 1024, 2048, 1024, e);
            GSYNC();
            TCAT(2); rg_scan_phase(a, vb, k2, lds);
            GSYNC();
#ifdef SKEW_ITERS
            if (okl && myx >= 4u) { for (int i_ = 0; i_ < SKEW_ITERS; ++i_) __builtin_amdgcn_s_sleep(127); }
#endif
            TCAT(5); rg_out_phase(a, vb, lds);
            A2 = (const bf16_t*)((const unsigned char*)ACT + ((size_t)8 << 20)); B2 = (const bf16_t*)(a.ws + OFF_WRO) + (size_t)k2 * 1024 * 1024; K2 = 1024;
            LSYNC();
        } else {
            TCAT(0); EpiSplit<1> e; e.O0 = ACT; e.O1 = nullptr; e.half = 2048; e.vstat = (float*)(a.ws + OFF_VSTAT);
            run_gemm(lds, cg_, H, ARS_H, (const bf16_t*)(a.ws + OFF_WGI) + (size_t)k2 * 4096 * 1024, 4096, 1024, e);
            LSYNC();
            TCAT(6); gm_gate_phase(a, vb, k2, lds);
            A2 = ACT; B2 = (const bf16_t*)(a.ws + OFF_WGO) + (size_t)k2 * 1024 * 2048; K2 = 2048;
            LSYNC();
        }
        TCAT(0);
        { EpiOutSsq e; e.O = (si & 1) ? (bf16_t*)(a.ws + OFF_O2) : O; e.ssq = (si & 1) ? (float*)(a.ws + OFF_SSQ2) : SSQ; run_gemm(lds, cg_, A2, REGB, B2, 1024, K2, e); }
        LSYNC();
        TCAT(1); ew_phase(a, vb, si, si < 11 ? si + 1 : -1, (si & 1) ? 2 : 1, si <= 1 ? a.x : a.out, a.out, H);
        LSYNC();
    }
#ifdef TPROBE
    {
        float* TM = (float*)(a.ws + OFF_C2);
        if (vb == 0 && threadIdx.x == 0) TM[0] = (float)tacc * 0.01f * TSCALE;
        xcd_barrier(xb);
        const float eps_ = TM[0];
        for (int r = 0; r < 128; ++r) { float* p = a.out + (size_t)(vb * 128 + r) * D; for (int c_ = threadIdx.x; c_ < D; c_ += 512) p[c_] *= (1.0f + eps_); }
    }
#endif
}

extern "C" void kernel_launch(void* const* d_in, const int* in_sizes, int n_in, void* d_out, int out_size, void* d_ws, size_t ws_size, hipStream_t stream) {
    static int grid_blocks = 0;
    if (grid_blocks == 0) {
        if (n_in != 23 || out_size != T * D || ws_size < WS_END) { fprintf(stderr, "kernel_launch: unexpected shapes (n_in %d out %d ws %zu need %zu)\n", n_in, out_size, ws_size, (size_t)WS_END); grid_blocks = -1; return; }
        int dev = 0, cus = 0, per_cu = 0;
        hipGetDevice(&dev);
        hipDeviceGetAttribute(&cus, hipDeviceAttributeMultiprocessorCount, dev);
        if (hipFuncSetAttribute((const void*)fwd_megakernel, hipFuncAttributeMaxDynamicSharedMemorySize, LDS_BYTES) != hipSuccess) { fprintf(stderr, "kernel_launch: hipFuncSetAttribute failed\n"); (void)hipGetLastError(); }
        if (hipOccupancyMaxActiveBlocksPerMultiprocessor(&per_cu, (const void*)fwd_megakernel, 512, LDS_BYTES) != hipSuccess || per_cu < 1) { fprintf(stderr, "kernel_launch: occupancy query gave %d\n", per_cu); (void)hipGetLastError(); per_cu = 1; }
        grid_blocks = cus * 1;
        if (grid_blocks <= 0) grid_blocks = 256;
    }
    if (grid_blocks < 0) return;
    Args a{};
    const float** ap = (const float**)&a;
    for (int i = 0; i < 23; ++i) ap[i] = (const float*)d_in[i];
    a.out = (float*)d_out; a.ws = (unsigned char*)d_ws;
    if (hipMemsetAsync((unsigned char*)d_ws + OFF_BAR, 0, WS_END - OFF_BAR, stream) != hipSuccess) { fprintf(stderr, "kernel_launch: memset failed\n"); return; }
    void* args[] = {&a};
    hipError_t e = hipLaunchCooperativeKernel((const void*)fwd_megakernel, dim3(grid_blocks), dim3(512), args, LDS_BYTES, stream);
    if (e != hipSuccess) fprintf(stderr, "cooperative launch failed: %s (grid %d)\n", hipGetErrorString(e), grid_blocks);
}
```

```cpp
#include <hip/hip_runtime.h>
#include <hip/hip_cooperative_groups.h>
#include <cstdio>
namespace cg = cooperative_groups;
namespace pg8 {
#define PG8_LAS __attribute__((address_space(3)))
typedef unsigned short bf16_t;
typedef short bf16x8 __attribute__((ext_vector_type(8)));
typedef float f32x4 __attribute__((ext_vector_type(4)));
typedef unsigned u32x4 __attribute__((ext_vector_type(4)));
constexpr int BM = 256, BK = 64, HALF = 128, HTB = HALF * BK * 2  , STAGE_BYTES = 8 * HTB, NXCD = 8, WGM = 8;

__host__ __device__ __forceinline__ int lds_byte(int r, int c) { const int st = (r >> 4) * 2 + (c >> 5), rr = r & 15, cc = c & 31, ob = rr * 64 + cc * 2; return st * 1024 + (ob ^ (((ob >> 9) & 1) << 5)); }
__host__ __device__ __forceinline__ void stage_rc(int b, int& R, int& C) { const int st = b / 1024, sb = b % 1024, swz = sb ^ (((sb >> 9) & 1) << 5); R = (st >> 1) * 16 + swz / 64; C = (st & 1) * 32 + (swz % 64) / 2; }
__host__ __device__ __forceinline__ int perm32(int rho) { const int n = rho >> 4, i = rho & 15; return 8 * (i >> 2) + 4 * n + (i & 3); }

struct Unit { int pm, pn; };
struct Gemm { const bf16_t* A; const bf16_t* Bt; int M, N, K; size_t ars; };

struct StaticOrder {
    int nM, nN, nwg, G, c;
    __host__ __device__ void init(int M, int N, int G_, int c_) { nM = M / BM; nN = N / BM; nwg = nM * nN; G = G_; c = c_; }
    __host__ __device__ bool next(int i, Unit& u) const {
        const long L = (long)i * G + c; if (L >= nwg) return false;
        int wgid = (int)L; { const int q = nwg / NXCD, r = nwg % NXCD, xcd = wgid % NXCD, off = wgid / NXCD; wgid = (xcd < r ? xcd * (q + 1) : r * (q + 1) + (xcd - r) * q) + off; }
        const int nig = WGM * nN, gid = wgid / nig, fm = gid * WGM, gsz = (nM - fm) < WGM ? (nM - fm) : WGM;
        u.pm = fm + ((wgid % nig) % gsz); u.pn = (wgid % nig) / gsz; return true;
    }
    __device__ __forceinline__ void a_ready(const Unit&) const {}
    __device__ __forceinline__ void done(const Unit&) const {}
};
__device__ __forceinline__ unsigned cvt_pk_bf16(float lo, float hi) { unsigned r; asm volatile("v_cvt_pk_bf16_f32 %0, %1, %2" : "=v"(r) : "v"(lo), "v"(hi)); return r; }
template <class Epi, class Sched, bool STAMP = false>
__device__ __forceinline__ void gemm_phase(PG8_LAS unsigned char* lds, const Gemm g, const Sched& S, const Epi& E, unsigned long long* stamps) {
    int tid_ = threadIdx.x; asm volatile("" : "+v"(tid_)); const int tid = tid_, wid = __builtin_amdgcn_readfirstlane(tid >> 6), lane = tid & 63, wr = wid >> 2, wc = wid & 3, fr = lane & 15, fq = lane >> 4;
    const int K = g.K, nt = K / BK;
    int ts_lo = 0, ts_hi = 0, nts = 0; const unsigned long long rt_entry = STAMP ? (unsigned long long)wall_clock64() : 0ull;
#define PG8_STAMP() do { if (STAMP && wid == 0 && nts < 64) { const unsigned long long _c = (unsigned long long)clock64(); \
        ts_lo = (lane == nts) ? (int)(unsigned)_c : ts_lo; ts_hi = (lane == nts) ? (int)(unsigned)(_c >> 32) : ts_hi; ++nts; } } while (0)
    PG8_STAMP();
    unsigned voffA[2], voffB[2];
#pragma unroll
    for (int i = 0; i < 2; ++i) { int R, C; stage_rc(tid * 16 + i * 8192, R, C); const int Rb = Epi::PERM ? ((R & ~31) + perm32(R & 31)) : R;
        voffA[i] = (unsigned)(R * K + C) * 2u; voffB[i] = (unsigned)(Rb * K + C) * 2u; }
    const size_t kstep = (size_t)(BK * 2);
    const size_t hstep = (size_t)HALF * K * 2;
    const size_t tstep = 2 * hstep;
    const unsigned ldsw = (unsigned)wid * 1024u;
    const int aoff = lds_byte(wr * 64 + fr, fq * 8), boff = lds_byte(wc * 32 + fr, fq * 8);
#define PG8_SA(b, h) (((b) * 2 + (h)) * HTB)
#define PG8_SB(b, h) ((4 + (b) * 2 + (h)) * HTB)
#define PG8_STAGE(bufoff, gbase, voff) do { _Pragma("unroll") for (int _i = 0; _i < 2; ++_i) \
        __builtin_amdgcn_global_load_lds((const unsigned*)((const char*)(gbase) + (voff)[_i]), (PG8_LAS unsigned*)(lds + (bufoff) + ldsw + _i * 8192), 16, 0, 0); } while (0)
#define PG8_LDA(dst, b, h) do { _Pragma("unroll") for (int m = 0; m < 4; ++m) _Pragma("unroll") for (int k = 0; k < 2; ++k) dst[m][k] = *(const PG8_LAS bf16x8*)(lds + PG8_SA(b, h) + aoff + m * 2048 + k * 1024); } while (0)
#define PG8_LDB(dst, b, h) do { _Pragma("unroll") for (int n = 0; n < 2; ++n) _Pragma("unroll") for (int k = 0; k < 2; ++k) dst[n][k] = *(const PG8_LAS bf16x8*)(lds + PG8_SB(b, h) + boff + n * 2048 + k * 1024); } while (0)
#define PG8_MMA(ai, bj, At, Bt) do { __builtin_amdgcn_s_setprio(1); _Pragma("unroll") for (int m = 0; m < 4; ++m) _Pragma("unroll") for (int n = 0; n < 2; ++n) _Pragma("unroll") for (int k = 0; k < 2; ++k) \
        acc[ai][bj][m][n] = __builtin_amdgcn_mfma_f32_16x16x32_bf16(Bt[n][k], At[m][k], acc[ai][bj][m][n], 0, 0, 0); __builtin_amdgcn_s_setprio(0); } while (0)
#define PG8_WAIT_V(n) asm volatile("s_waitcnt vmcnt(" #n ")" ::: "memory")
#define PG8_WAIT_L(n) asm volatile("s_waitcnt lgkmcnt(" #n ")" ::: "memory")
#define PG8_BAR __builtin_amdgcn_s_barrier()
#define PG8_SCHED __builtin_amdgcn_sched_barrier(0)
    Unit cur, nxt; int ui = 0;
    if (!S.next(0, cur)) return;
    f32x4 acc[2][2][4][2];
#pragma unroll
    for (int a = 0; a < 2; ++a)
#pragma unroll
        for (int b = 0; b < 2; ++b)
#pragma unroll
            for (int m = 0; m < 4; ++m)
#pragma unroll
                for (int n = 0; n < 2; ++n) acc[a][b][m][n] = (f32x4){0.f, 0.f, 0.f, 0.f};
    bf16x8 At[4][2], B0[2][2], B1[2][2];
    const char* cA = (const char*)g.A + (size_t)(cur.pm >> 4) * g.ars + (size_t)(cur.pm & 15) * tstep; const char* cB = (const char*)g.Bt + (size_t)cur.pn * tstep;
    S.a_ready(cur);
    PG8_STAGE(PG8_SB(0, 0), cB, voffB); PG8_STAGE(PG8_SA(0, 0), cA, voffA); PG8_STAGE(PG8_SB(0, 1), cB + hstep, voffB); PG8_STAGE(PG8_SA(0, 1), cA + hstep, voffA);
    if (wr == 1) PG8_BAR;
    PG8_WAIT_V(4); PG8_BAR;
    PG8_STAGE(PG8_SB(1, 0), cB + kstep, voffB); PG8_STAGE(PG8_SA(1, 0), cA + kstep, voffA); PG8_STAGE(PG8_SB(1, 1), cB + hstep + kstep, voffB);
    PG8_WAIT_V(6); PG8_BAR;
    PG8_STAMP();
    for (;;) {
        const bool has_next = S.next(ui + 1, nxt);
        const char* nA = has_next ? (const char*)g.A + (size_t)(nxt.pm >> 4) * g.ars + (size_t)(nxt.pm & 15) * tstep : cA; const char* nB = has_next ? (const char*)g.Bt + (size_t)nxt.pn * tstep : cB;
        for (int t = 0; t < nt; t += 2) {
            const bool last = (t == nt - 2);
            const char* a1 = cA + (size_t)(t + 1) * kstep;
            const char* a2 = last ? nA : cA + (size_t)(t + 2) * kstep; const char* b2 = last ? nB : cB + (size_t)(t + 2) * kstep;
            const char* a3 = a2 + kstep; const char* b3 = b2 + kstep;
            if (last && has_next) S.a_ready(nxt);
            PG8_LDB(B0, 0, 0); PG8_SCHED; PG8_LDA(At, 0, 0); PG8_STAGE(PG8_SA(1, 1), a1 + hstep, voffA);
            PG8_WAIT_L(8); PG8_BAR; PG8_WAIT_L(0); PG8_MMA(0, 0, At, B0); PG8_BAR; PG8_SCHED;
            PG8_LDB(B1, 0, 1); PG8_STAGE(PG8_SB(0, 0), b2, voffB);
            PG8_BAR; PG8_WAIT_L(0); PG8_MMA(0, 1, At, B1); PG8_BAR;
            PG8_LDA(At, 0, 1); PG8_STAGE(PG8_SA(0, 0), a2, voffA);
            PG8_BAR; PG8_WAIT_L(0); PG8_MMA(1, 0, At, B0); PG8_BAR; PG8_SCHED;
            PG8_STAGE(PG8_SB(0, 1), b2 + hstep, voffB);
            PG8_WAIT_V(6); PG8_BAR; PG8_MMA(1, 1, At, B1); PG8_BAR;
            PG8_LDB(B0, 1, 0); PG8_SCHED; PG8_LDA(At, 1, 0); PG8_STAGE(PG8_SA(0, 1), a2 + hstep, voffA);
            PG8_WAIT_L(8); PG8_BAR; PG8_WAIT_L(0); PG8_MMA(0, 0, At, B0); PG8_BAR; PG8_SCHED;
            PG8_LDB(B1, 1, 1); PG8_STAGE(PG8_SB(1, 0), b3, voffB);
            PG8_BAR; PG8_WAIT_L(0); PG8_MMA(0, 1, At, B1); PG8_BAR;
            PG8_LDA(At, 1, 1); PG8_STAGE(PG8_SA(1, 0), a3, voffA);
            PG8_BAR; PG8_WAIT_L(0); PG8_MMA(1, 0, At, B0); PG8_BAR; PG8_SCHED;
            PG8_STAGE(PG8_SB(1, 1), b3 + hstep, voffB);
            PG8_WAIT_V(6); PG8_BAR; PG8_MMA(1, 1, At, B1); PG8_BAR;
        }
        PG8_STAMP();
        if constexpr (!Epi::AFTER_DRAIN) { E(acc, cur, wr, wc, fr, fq); S.done(cur); }
        PG8_STAMP();
        if (!has_next) break;
#pragma unroll
        for (int a = 0; a < 2; ++a)
#pragma unroll
            for (int b = 0; b < 2; ++b)
#pragma unroll
                for (int m = 0; m < 4; ++m)
#pragma unroll
                    for (int n = 0; n < 2; ++n) acc[a][b][m][n] = (f32x4){0.f, 0.f, 0.f, 0.f};
        cur = nxt; cA = nA; cB = nB; ++ui;
    }
    PG8_WAIT_V(0);
    if (wr == 0) PG8_BAR;
    PG8_BAR;
    if constexpr (Epi::AFTER_DRAIN) { E.fused(acc, cur, wr, wc, fr, fq, lds, wid, lane); S.done(cur); }
    PG8_STAMP();
    if (STAMP && wid == 0) { stamps[lane] = lane < nts ? (((unsigned long long)(unsigned)ts_hi << 32) | (unsigned)ts_lo) : 0ull;
        if (lane == 62) stamps[62] = rt_entry; if (lane == 63) stamps[63] = (unsigned long long)wall_clock64(); }
#undef PG8_STAMP
#undef PG8_SA
#undef PG8_SB
#undef PG8_STAGE
#undef PG8_LDA
#undef PG8_LDB
#undef PG8_MMA
#undef PG8_WAIT_V
#undef PG8_WAIT_L
#undef PG8_BAR
#undef PG8_SCHED
}
}
#define LAS PG8_LAS
#define XB_TMO      128
#define XB_XCNT(j)  (256  + 64 * (j))
#define XB_XSUB(j)  (1280 + 64 * (j))
#define XB_XGEN(j)  (2304 + 64 * (j))
#define XB_TOP      3328
#define XB_TOPGEN   3392
#define XCD_BAR_WORDS 3456
#define XB_SPIN_CAP (1u << 18)

__device__ __forceinline__ unsigned xb_ld(unsigned* p)              { return __hip_atomic_load(p, __ATOMIC_RELAXED, __HIP_MEMORY_SCOPE_AGENT); }
__device__ __forceinline__ unsigned xb_add(unsigned* p, unsigned v) { return __hip_atomic_fetch_add(p, v, __ATOMIC_RELAXED, __HIP_MEMORY_SCOPE_AGENT); }
__device__ __forceinline__ unsigned xb_xcc_id() { return (unsigned)__builtin_amdgcn_s_getreg((3 << 11) | 20) & 0xFu; }
#define XB_SPIN(cond, bar) do { unsigned _sp = 0; while (cond) { __builtin_amdgcn_s_sleep(1); \
    if ((++_sp & 255u) == 0u) { if (xb_ld(&(bar)[XB_TMO])) break; if (_sp > XB_SPIN_CAP) { atomicAdd(&(bar)[XB_TMO], 1u); break; } } } } while (0)

struct XcdBarrier {
    unsigned* bar; unsigned x;
    volatile LAS unsigned* st;
};

__device__ __forceinline__ XcdBarrier xcd_barrier_post(unsigned* bar, volatile LAS unsigned* st) {
    XcdBarrier b; b.bar = bar; b.x = xb_xcc_id(); b.st = st;
    if (threadIdx.x == 0) (void)xb_add(&bar[XB_XCNT(b.x)], 1u);
    return b;
}
__device__ __forceinline__ void xcd_barrier_complete(unsigned* bar, unsigned x, unsigned& nloc, unsigned& nx) {
    const unsigned G = gridDim.x * gridDim.y * gridDim.z;
    unsigned sum, cnt, mine, sp = 0u;
    for (;;) {
        sum = 0u; cnt = 0u; mine = 0u;
#pragma unroll
        for (unsigned j = 0; j < 16; ++j) { const unsigned c = xb_ld(&bar[XB_XCNT(j)]); sum += c; cnt += (c > 0u) ? 1u : 0u; mine = (j == x) ? c : mine; }
        if (sum == G) break;
        __builtin_amdgcn_s_sleep(1);
        if ((++sp & 255u) == 0u) { if (xb_ld(&bar[XB_TMO])) break; if (sp > XB_SPIN_CAP) { atomicAdd(&bar[XB_TMO], 1u); break; } }
    }
    nloc = mine > 0u ? mine : 1u; nx = cnt > 0u ? cnt : 1u;
}

__device__ __forceinline__ void xcd_barrier(const XcdBarrier& b) {
    asm volatile("s_waitcnt vmcnt(0)" ::: "memory");
    __syncthreads();
    if (threadIdx.x == 0) {
        unsigned* bar = b.bar;
        __builtin_amdgcn_s_waitcnt(0);
        unsigned nloc = b.st[0], nx = b.st[1];
        if (nloc == 0u) { xcd_barrier_complete(bar, b.x, nloc, nx); b.st[0] = nloc; b.st[1] = nx; }
        const unsigned old = xb_add(&bar[XB_XSUB(b.x)], 1u);
        const unsigned gen = old / nloc;
        if (old + 1u == (gen + 1u) * nloc) {
            __builtin_amdgcn_fence(__ATOMIC_RELEASE, "agent");
            asm volatile("s_waitcnt vmcnt(0)" ::: "memory");
            const unsigned og = xb_add(&bar[XB_TOP], 1u);
            const unsigned tg = og / nx;
            if (og + 1u == (tg + 1u) * nx) xb_add(&bar[XB_TOPGEN], 1u);
            else XB_SPIN(xb_ld(&bar[XB_TOPGEN]) == tg, bar);
            __builtin_amdgcn_fence(__ATOMIC_ACQUIRE, "agent");
            xb_add(&bar[XB_XGEN(b.x)], 1u);
            asm volatile("s_waitcnt vmcnt(0)" ::: "memory");
        } else {
            XB_SPIN(xb_ld(&bar[XB_XGEN(b.x)]) == gen, bar);
            __builtin_amdgcn_fence(__ATOMIC_ACQUIRE, "agent");
            asm volatile("s_waitcnt vmcnt(0)" ::: "memory");
        }
    }
    __syncthreads();
}

using namespace pg8;
#define LAS PG8_LAS
typedef unsigned u32x2 __attribute__((ext_vector_type(2)));

constexpr int T = 32768, D = 1024, SEQ = 16384, DFF = 2816, NMOD = 9216;
constexpr float EPS = 1e-6f;
constexpr int LDS_BYTES = 147456;

constexpr size_t OFF_MOD = 0;
constexpr size_t OFF_C2 = OFF_MOD + 294912;
constexpr size_t OFF_SSQ = OFF_C2 + 8192;
constexpr size_t OFF_VSTAT = OFF_SSQ + 2097152;
constexpr size_t OFF_CHA = OFF_VSTAT + 8388608;
constexpr size_t OFF_CHH = OFF_CHA + 1048576;
constexpr size_t OFF_WFI = OFF_CHH + 1048576;
constexpr size_t OFF_WFO = OFF_WFI + 92274688;
constexpr size_t OFF_WRI = OFF_WFO + 46137344;
constexpr size_t OFF_WRG = OFF_WRI + 8388608;
constexpr size_t OFF_WRO = OFF_WRG + 1048576;
constexpr size_t OFF_WGI = OFF_WRO + 4194304;
constexpr size_t OFF_WGS = OFF_WGI + 16777216;
constexpr size_t OFF_WGO = OFF_WGS + 524288;
constexpr size_t OFF_H = OFF_WGO + 8388608;
constexpr size_t OFF_O = OFF_H + 67108864;
constexpr size_t OFF_ACT = OFF_O + 67108864;
constexpr size_t OFF_BAR = OFF_ACT + 268435456;
constexpr size_t OFF_LOC = OFF_BAR + 16384;
constexpr size_t OFF_NSP = OFF_LOC + 4096;
constexpr size_t OFF_O2 = OFF_NSP + 8192;
constexpr size_t OFF_SSQ2 = OFF_O2 + 67108864;
constexpr size_t WS_END = OFF_SSQ2 + 2097152;
constexpr size_t REGB = 33554432;

struct Args {
    const float *x, *c, *ada_w, *ada_b, *norm_pre, *norm_post, *ffn_w_in, *ffn_w_out, *rg_w_in, *rg_conv_w, *rg_conv_b, *rg_w_a, *rg_b_a, *rg_w_x, *rg_b_x, *rg_lambda,
        *rg_w_out, *gm_w_in, *gm_ln_g, *gm_ln_b, *gm_w_s, *gm_b_s, *gm_w_out;
    float* out; unsigned char* ws;
};

__device__ __forceinline__ float bf_lo(unsigned w) { return __uint_as_float(w << 16); }
__device__ __forceinline__ float bf_hi(unsigned w) { return __uint_as_float(w & 0xffff0000u); }
__device__ __forceinline__ bf16_t f2bf(float f) { unsigned u = __float_as_uint(f); u += 0x7FFFu + ((u >> 16) & 1u); return (bf16_t)(u >> 16); }
__device__ __forceinline__ float sigm(float x) { return __builtin_amdgcn_rcpf(1.0f + __expf(-x)); }
__device__ __forceinline__ float silu_f(float x) { return x * sigm(x); }
__device__ __forceinline__ float gelu_t(float x) { const float t = x * fmaf(-0.10294324f, x * x, -2.3022082f); return x * __builtin_amdgcn_rcpf(1.0f + __builtin_amdgcn_exp2f(t)); }
__device__ __forceinline__ u32x4 pack8(const f32x4 a, const f32x4 b) { u32x4 w; w.x = cvt_pk_bf16(a[0], a[1]); w.y = cvt_pk_bf16(a[2], a[3]); w.z = cvt_pk_bf16(b[0], b[1]); w.w = cvt_pk_bf16(b[2], b[3]); return w; }
__device__ __forceinline__ void unpack8(const u32x4 w, float (&f)[8]) { f[0] = bf_lo(w.x); f[1] = bf_hi(w.x); f[2] = bf_lo(w.y); f[3] = bf_hi(w.y); f[4] = bf_lo(w.z); f[5] = bf_hi(w.z); f[6] = bf_lo(w.w); f[7] = bf_hi(w.w); }

__device__ __forceinline__ size_t act_off(int row, int pitchB, size_t sub) { return (size_t)(row >> 12) * REGB + sub + (size_t)(row & 4095) * (size_t)pitchB; }
__device__ __forceinline__ void xcc_local_barrier(unsigned* cnt, unsigned nloc) {
    asm volatile("s_waitcnt vmcnt(0)" ::: "memory");
    __syncthreads();
    if (threadIdx.x == 0) {
        __builtin_amdgcn_s_waitcnt(0);
        const unsigned old = xb_add(cnt, 1u); const unsigned target = (old / nloc + 1u) * nloc; unsigned sp = 0u;
        while (xb_ld(cnt) < target) { __builtin_amdgcn_s_sleep(1); if (++sp > (1u << 20)) break; }
        __builtin_amdgcn_fence(__ATOMIC_ACQUIRE, "agent");
        asm volatile("s_waitcnt vmcnt(0)" ::: "memory");
    }
    __syncthreads();
}

struct EpiSwiglu {
    static constexpr bool PERM = true, AFTER_DRAIN = false;
    bf16_t* O;
    __device__ __forceinline__ void operator()(const f32x4 (&acc)[2][2][4][2], const Unit& u, int wr, int wc, int fr, int fq) const {
        const int row0 = u.pm * BM + wr * 64 + fr, col0 = u.pn * 128 + wc * 32 + 8 * fq;
#pragma unroll
        for (int ai = 0; ai < 2; ++ai)
#pragma unroll
            for (int m = 0; m < 4; ++m) {
                f32x4 v0, v1;
#pragma unroll
                for (int j = 0; j < 4; ++j) { v0[j] = silu_f(acc[ai][0][m][0][j]) * acc[ai][1][m][0][j]; v1[j] = silu_f(acc[ai][0][m][1][j]) * acc[ai][1][m][1][j]; }
                *(u32x4*)((unsigned char*)O + act_off(row0 + ai * HALF + m * 16, DFF * 2, 0) + (size_t)col0 * 2) = pack8(v0, v1);
            }
    }
};
struct EpiOutSsq {
    static constexpr bool PERM = true, AFTER_DRAIN = false;
    bf16_t* O; float* ssq;
    __device__ __forceinline__ void operator()(const f32x4 (&acc)[2][2][4][2], const Unit& u, int wr, int wc, int fr, int fq) const {
        const int row0 = u.pm * BM + wr * 64 + fr, col0 = u.pn * BM + wc * 32 + 8 * fq;
#pragma unroll
        for (int ai = 0; ai < 2; ++ai)
#pragma unroll
            for (int m = 0; m < 4; ++m) {
                const int row = row0 + ai * HALF + m * 16; float s = 0.f;
#pragma unroll
                for (int bj = 0; bj < 2; ++bj) { const f32x4 v0 = acc[ai][bj][m][0], v1 = acc[ai][bj][m][1];
                    s += (v0[0] * v0[0] + v0[1] * v0[1]) + (v0[2] * v0[2] + v0[3] * v0[3]) + (v1[0] * v1[0] + v1[1] * v1[1]) + (v1[2] * v1[2] + v1[3] * v1[3]);
                    *(u32x4*)(O + (size_t)row * D + col0 + bj * HALF) = pack8(v0, v1); }
                s += __shfl_xor(s, 16); s += __shfl_xor(s, 32);
                if (fq == 0) ssq[(size_t)row * 16 + u.pn * 4 + wc] = s;
            }
    }
};
template <int GELU> struct EpiSplit {
    static constexpr bool PERM = true, AFTER_DRAIN = false;
    bf16_t* O0; bf16_t* O1; int half; float* vstat;
    __device__ __forceinline__ void operator()(const f32x4 (&acc)[2][2][4][2], const Unit& u, int wr, int wc, int fr, int fq) const {
        int colt = u.pn * BM; const bool second = colt >= half; if (second) colt -= half; const size_t sub = second ? (size_t)4096 * half * 2 : 0;
        const int row0 = u.pm * BM + wr * 64 + fr, col0 = colt + wc * 32 + 8 * fq; const int vt = colt >> 8;
#pragma unroll
        for (int ai = 0; ai < 2; ++ai)
#pragma unroll
            for (int m = 0; m < 4; ++m) {
                const int row = row0 + ai * HALF + m * 16; float s = 0.f, q = 0.f;
#pragma unroll
                for (int bj = 0; bj < 2; ++bj) { f32x4 v0 = acc[ai][bj][m][0], v1 = acc[ai][bj][m][1];
                    if (GELU) {
#pragma unroll
                        for (int j = 0; j < 4; ++j) { v0[j] = gelu_t(v0[j]); v1[j] = gelu_t(v1[j]); }
                        if (second) {
                        s += (v0[0] + v0[1]) + (v0[2] + v0[3]) + (v1[0] + v1[1]) + (v1[2] + v1[3]);
                        q += (v0[0] * v0[0] + v0[1] * v0[1]) + (v0[2] * v0[2] + v0[3] * v0[3]) + (v1[0] * v1[0] + v1[1] * v1[1]) + (v1[2] * v1[2] + v1[3] * v1[3]); } }
                    *(u32x4*)((unsigned char*)O0 + act_off(row, half * 2, sub) + (size_t)(col0 + bj * HALF) * 2) = pack8(v0, v1); }
                if (GELU && second) { s += __shfl_xor(s, 16); s += __shfl_xor(s, 32); q += __shfl_xor(q, 16); q += __shfl_xor(q, 32);
                    if (fq == 0) { float* p = vstat + ((size_t)row * 32 + vt * 4 + wc) * 2; p[0] = s; p[1] = q; } }
            }
    }
};

__device__ __forceinline__ void prep_phase(const Args& a, LAS unsigned char* lds) {
    int tid_ = threadIdx.x; asm volatile("" : "+v"(tid_)); const int tid = tid_, wid = tid >> 6, lane = tid & 63;
    float* MOD = (float*)(a.ws + OFF_MOD);
    {
        LAS float* sc = (LAS float*)lds;
        LAS float* red = sc + 2048;
        for (int i = tid; i < 2048; i += 512) sc[i] = silu_f(a.c[i]);
        __syncthreads();
        for (int it = blockIdx.x; it < 576; it += gridDim.x) {
            const int l = it / 144, nb = it % 144;
            const float* w = a.ada_w + ((size_t)l * 1024 + wid * 128) * NMOD + nb * 64 + lane;
            float a0 = 0.f, a1 = 0.f;
#pragma unroll 16
            for (int k = 0; k < 128; ++k) { const float wv = w[(size_t)k * NMOD]; a0 += sc[wid * 128 + k] * wv; a1 += sc[1024 + wid * 128 + k] * wv; }
            red[(wid * 64 + lane) * 2] = a0; red[(wid * 64 + lane) * 2 + 1] = a1;
            __syncthreads();
            if (tid < 128) { const int ln = tid & 63, b = tid >> 6; float s = 0.f;
#pragma unroll
                for (int w2 = 0; w2 < 8; ++w2) s += red[(w2 * 64 + ln) * 2 + b];
                MOD[(size_t)(l * 2 + b) * NMOD + nb * 64 + ln] = s + a.ada_b[(size_t)l * NMOD + nb * 64 + ln]; }
            __syncthreads();
        }
    }
    {
        LAS float* L = (LAS float*)lds;
        const bool bal = (gridDim.x == 256);
        const int tbeg = bal ? ((int)blockIdx.x < 64 ? (int)blockIdx.x * 18 : 1152 + ((int)blockIdx.x - 64) * 22) : (int)blockIdx.x;
        const int tend = bal ? tbeg + ((int)blockIdx.x < 64 ? 18 : 22) : 5376, tinc = bal ? 1 : (int)gridDim.x;
#define PREP_DECODE(tix_) \
            int t = (tix_), K, N, mode = 0; const float* src; bf16_t* dst; \
            if (t < 2816) { const int mi = t / 352; t %= 352; src = a.ffn_w_in + (size_t)mi * 1024 * 5632; dst = (bf16_t*)(a.ws + OFF_WFI) + (size_t)mi * 5632 * 1024; K = 1024; N = 5632; mode = 1; } \
            else if ((t -= 2816) < 1408) { const int mi = t / 176; t %= 176; src = a.ffn_w_out + (size_t)mi * 2816 * 1024; dst = (bf16_t*)(a.ws + OFF_WFO) + (size_t)mi * 1024 * 2816; K = 2816; N = 1024; } \
            else if ((t -= 1408) < 256) { const int mi = t / 128; t %= 128; src = a.rg_w_in + (size_t)mi * 1024 * 2048; dst = (bf16_t*)(a.ws + OFF_WRI) + (size_t)mi * 2048 * 1024; K = 1024; N = 2048; } \
            else if ((t -= 256) < 128) { const int mi = t / 64; t %= 64; src = a.rg_w_out + (size_t)mi * 1024 * 1024; dst = (bf16_t*)(a.ws + OFF_WRO) + (size_t)mi * 1024 * 1024; K = 1024; N = 1024; } \
            else if ((t -= 128) < 512) { const int mi = t / 256; t %= 256; src = a.gm_w_in + (size_t)mi * 1024 * 4096; dst = (bf16_t*)(a.ws + OFF_WGI) + (size_t)mi * 4096 * 1024; K = 1024; N = 4096; } \
            else { t -= 512; const int mi = t / 128; t %= 128; src = a.gm_w_out + (size_t)mi * 2048 * 1024; dst = (bf16_t*)(a.ws + OFF_WGO) + (size_t)mi * 1024 * 2048; K = 2048; N = 1024; } \
            const int ntn = N >> 8, kt = t / ntn, nt = t % ntn, k0 = kt * 64, n0 = nt * 256;
#define PREP_LOAD() _Pragma("unroll") for (int i = 0; i < 8; ++i) { const int idx = tid + 512 * i, row = idx >> 6, c4 = idx & 63; v[i] = *(const f32x4*)(src + (size_t)(k0 + row) * N + n0 + c4 * 4); }
        f32x4 v[8];
        if (tbeg < tend) { PREP_DECODE(tbeg) PREP_LOAD() (void)dst; (void)K; (void)mode; }
        for (int tix = tbeg; tix < tend; tix += tinc) {
#pragma unroll
            for (int i = 0; i < 8; ++i) { const int idx = tid + 512 * i, row = idx >> 6, c4 = idx & 63; *(LAS f32x4*)(L + row * 260 + c4 * 4) = v[i]; }
            if (tix + tinc < tend) { PREP_DECODE(tix + tinc) PREP_LOAD() (void)dst; (void)K; (void)mode; }
            __syncthreads();
            PREP_DECODE(tix)
            (void)src; (void)ntn; (void)kt; (void)nt;
            const int n = tid & 255, kh = tid >> 8, c = n0 + n; int drow = c;
            if (mode == 1) { const int up = c >= 2816, cc = up ? c - 2816 : c; drow = (cc >> 7) * 256 + up * 128 + (cc & 127); }
            bf16_t* dp = dst + (size_t)drow * K + k0 + kh * 32;
#pragma unroll
            for (int p = 0; p < 4; ++p) { f32x4 f0, f1;
#pragma unroll
                for (int j = 0; j < 4; ++j) { f0[j] = L[(kh * 32 + p * 8 + j) * 260 + n]; f1[j] = L[(kh * 32 + p * 8 + 4 + j) * 260 + n]; }
                *(u32x4*)(dp + p * 8) = pack8(f0, f1); }
            __syncthreads();
        }
#undef PREP_DECODE
#undef PREP_LOAD
    }
    {
        bf16_t* WRG = (bf16_t*)(a.ws + OFF_WRG);
        for (int idx = blockIdx.x * 512 + tid; idx < 524288; idx += gridDim.x * 512) {
            const int d = idx & 127, e = (idx >> 7) & 127, which = (idx >> 14) & 1, h = (idx >> 15) & 7, k2 = idx >> 18;
            const float* s = (which ? a.rg_w_x : a.rg_w_a) + (((size_t)(k2 * 8 + h) * 128 + d) * 128 + e);
            WRG[idx] = f2bf(*s);
        }
    }
    {
        float* NSP = (float*)(a.ws + OFF_NSP);
        for (int i = blockIdx.x * 512 + tid; i < 2048; i += gridDim.x * 512) NSP[i] = -8.0f * log1pf(expf(-a.rg_lambda[i])) * 1.4426950408889634f;
    }
    {
        bf16_t* WGS = (bf16_t*)(a.ws + OFF_WGS); float* C2 = (float*)(a.ws + OFF_C2);
        for (int row = blockIdx.x * 8 + wid; row < 2048; row += gridDim.x * 8) {
            const int t = row & 127; float sum = 0.f;
#pragma unroll
            for (int s = lane; s < 128; s += 64) { float w = a.gm_w_s[(size_t)row * 128 + s]; if (s > t) w = 0.f; WGS[(size_t)row * 128 + s] = f2bf(w); sum += w; }
#pragma unroll
            for (int o = 32; o >= 1; o >>= 1) sum += __shfl_xor(sum, o);
            if (lane == 0) C2[row] = sum;
        }
    }
}

__device__ __forceinline__ void ew_phase(const Args& a, int vb, int sp, int sn, int wm, const float* xin, float* xout, bf16_t* H) {
    int tid_ = threadIdx.x; asm volatile("" : "+v"(tid_)); const int tid = tid_, wid = tid >> 6, lane = tid & 63;
    const float* MOD = (const float*)(a.ws + OFF_MOD);
    const float* SSQc = (const float*)(a.ws + ((sp & 1) ? OFF_SSQ2 : OFF_SSQ)); const bf16_t* Oc = (const bf16_t*)(a.ws + ((sp & 1) ? OFF_O2 : OFF_O));
    const float* SSQp = (const float*)(a.ws + OFF_SSQ); const bf16_t* Op = (const bf16_t*)(a.ws + OFF_O);
    for (int rb = vb * 8 + wid; rb < T / 16; rb += gridDim.x * 8) {
        const int row0 = rb * 16, b = row0 >> 14;
        f32x4 pg[4], pgp[4], ps[4], pb[4];
#pragma unroll
        for (int k = 0; k < 4; ++k) { pg[k] = (f32x4){0.f, 0.f, 0.f, 0.f}; pgp[k] = pg[k]; ps[k] = pg[k]; pb[k] = pg[k]; }
        if (sp >= 0) { const int l = sp / 3, j = sp % 3; const float resw = (j == 1) ? 1.0f : 0.5f;
            const float* gate = MOD + (size_t)(l * 2 + b) * NMOD + j * 3072 + 2048 + 4 * lane; const float* gp = a.norm_post + (size_t)(l * 3 + j) * D + 4 * lane;
#pragma unroll
            for (int k = 0; k < 4; ++k) pg[k] = resw * (*(const f32x4*)(gate + 256 * k)) * (*(const f32x4*)(gp + 256 * k)); }
        if (wm == 2) { const int s2 = sp - 1, l = s2 / 3, j = s2 % 3; const float resw = (j == 1) ? 1.0f : 0.5f;
            const float* gate = MOD + (size_t)(l * 2 + b) * NMOD + j * 3072 + 2048 + 4 * lane; const float* gp = a.norm_post + (size_t)(l * 3 + j) * D + 4 * lane;
#pragma unroll
            for (int k = 0; k < 4; ++k) pgp[k] = resw * (*(const f32x4*)(gate + 256 * k)) * (*(const f32x4*)(gp + 256 * k)); }
        if (sn >= 0) { const int l = sn / 3, j = sn % 3;
            const float* shift = MOD + (size_t)(l * 2 + b) * NMOD + j * 3072 + 4 * lane; const float* gpre = a.norm_pre + (size_t)(l * 3 + j) * D + 4 * lane;
#pragma unroll
            for (int k = 0; k < 4; ++k) { ps[k] = (*(const f32x4*)(gpre + 256 * k)) * (1.0f + *(const f32x4*)(shift + 1024 + 256 * k)); pb[k] = *(const f32x4*)(shift + 256 * k); } }
        f32x4 xn[4]; u32x2 on[4], opn[4]; float sn_ = 0.f, spn_ = 0.f;
#pragma unroll
        for (int k = 0; k < 4; ++k) { on[k] = (u32x2){0u, 0u}; opn[k] = on[k]; }
#define EW_LOADROW(rowi) do { const size_t ro_ = (size_t)(rowi) * D + 4 * lane; \
            _Pragma("unroll") for (int k = 0; k < 4; ++k) xn[k] = __builtin_nontemporal_load((const f32x4*)(xin + ro_ + 256 * k)); \
            if (sp >= 0) { sn_ = SSQc[(size_t)(rowi) * 16 + (lane & 15)]; \
                _Pragma("unroll") for (int k = 0; k < 4; ++k) on[k] = *(const u32x2*)(Oc + ro_ + 256 * k); } \
            if (wm == 2) { spn_ = SSQp[(size_t)(rowi) * 16 + (lane & 15)]; \
                _Pragma("unroll") for (int k = 0; k < 4; ++k) opn[k] = *(const u32x2*)(Op + ro_ + 256 * k); } } while (0)
        EW_LOADROW(row0);
        for (int rr = 0; rr < 16; ++rr) {
            const size_t ro = (size_t)(row0 + rr) * D + 4 * lane;
            f32x4 x[4]; u32x2 oc[4], opc[4]; float s = sn_, s2 = spn_;
#pragma unroll
            for (int k = 0; k < 4; ++k) { x[k] = xn[k]; oc[k] = on[k]; opc[k] = opn[k]; }
            if (rr < 15) EW_LOADROW(row0 + rr + 1);
            if (wm == 2) {
                s2 += __shfl_xor(s2, 1); s2 += __shfl_xor(s2, 2); s2 += __shfl_xor(s2, 4); s2 += __shfl_xor(s2, 8);
                const float rstd2 = rsqrtf(s2 * (1.0f / 1024.0f) + EPS);
#pragma unroll
                for (int k = 0; k < 4; ++k) { const u32x2 ow = opc[k]; const f32x4 o = (f32x4){bf_lo(ow.x), bf_hi(ow.x), bf_lo(ow.y), bf_hi(ow.y)}; x[k] += pgp[k] * (o * rstd2); }
            }
            if (sp >= 0) {
                s += __shfl_xor(s, 1); s += __shfl_xor(s, 2); s += __shfl_xor(s, 4); s += __shfl_xor(s, 8);
                const float rstd = rsqrtf(s * (1.0f / 1024.0f) + EPS);
#pragma unroll
                for (int k = 0; k < 4; ++k) { const u32x2 ow = oc[k]; const f32x4 o = (f32x4){bf_lo(ow.x), bf_hi(ow.x), bf_lo(ow.y), bf_hi(ow.y)};
                    x[k] += pg[k] * (o * rstd); if (wm == 2) __builtin_nontemporal_store(x[k], (f32x4*)(xout + ro + 256 * k)); }
            }
            if (sn >= 0) {
                float ss = 0.f;
#pragma unroll
                for (int k = 0; k < 4; ++k) ss += (x[k][0] * x[k][0] + x[k][1] * x[k][1]) + (x[k][2] * x[k][2] + x[k][3] * x[k][3]);
#pragma unroll
                for (int o = 32; o >= 1; o >>= 1) ss += __shfl_xor(ss, o);
                const float rs = rsqrtf(ss * (1.0f / 1024.0f) + EPS);
#pragma unroll
                for (int k = 0; k < 4; ++k) { const f32x4 hv = (x[k] * rs) * ps[k] + pb[k]; u32x2 w; w.x = cvt_pk_bf16(hv[0], hv[1]); w.y = cvt_pk_bf16(hv[2], hv[3]); *(u32x2*)(H + ro + 256 * k) = w; }
            }
        }
#undef EW_LOADROW
    }
}

__device__ __forceinline__ void rg_scan_phase(const Args& a, int vb, int k2, LAS unsigned char* lds) {
    int tid_ = threadIdx.x; asm volatile("" : "+v"(tid_)); const int tid = tid_, wid = tid >> 6, lane = tid & 63, fr = lane & 15, fq = lane >> 4;
    LAS float* XC = (LAS float*)lds; LAS float* SA = XC + 128 * 132; LAS float* SEG = SA + 128 * 132;
    unsigned char* AB = a.ws + OFF_ACT;
    float* CHA = (float*)(a.ws + OFF_CHA); float* CHH = (float*)(a.ws + OFF_CHH);
    const float* cw = a.rg_conv_w + (size_t)k2 * 4 * D; const float* cb = a.rg_conv_b + (size_t)k2 * D;
    for (int ch = vb; ch < 256; ch += gridDim.x) {
      const int t0 = ch * 128; const bool first = (t0 & (SEQ - 1)) == 0;
      u32x4 xq[7];
#define RG_PF_CONV(hh) do { const int c0_ = (hh) * 128 + (tid & 15) * 8; \
        _Pragma("unroll") for (int r = 0; r < 7; ++r) { const int tt = 4 * (tid >> 4) - 3 + r; \
            if (tt < 0 && first) xq[r] = (u32x4){0u, 0u, 0u, 0u}; else xq[r] = *(const u32x4*)(AB + act_off(t0 + tt, 2048, 0) + (size_t)c0_ * 2); } } while (0)
      RG_PF_CONV(0);
#pragma unroll 1
      for (int h = 0; h < 8; ++h) {
        {
            const int cg8 = tid & 15, tq = tid >> 4, c0 = h * 128 + cg8 * 8;
            float w[4][8], bias[8], xr[7][8];
#pragma unroll
            for (int k = 0; k < 4; ++k) { const f32x4 w0 = *(const f32x4*)(cw + k * D + c0), w1 = *(const f32x4*)(cw + k * D + c0 + 4);
#pragma unroll
                for (int j = 0; j < 4; ++j) { w[k][j] = w0[j]; w[k][4 + j] = w1[j]; } }
            { const f32x4 b0 = *(const f32x4*)(cb + c0), b1 = *(const f32x4*)(cb + c0 + 4);
#pragma unroll
                for (int j = 0; j < 4; ++j) { bias[j] = b0[j]; bias[4 + j] = b1[j]; } }
#pragma unroll
            for (int r = 0; r < 7; ++r) unpack8(xq[r], xr[r]);
#pragma unroll
            for (int q = 0; q < 4; ++q) { f32x4 o0, o1;
#pragma unroll
                for (int j = 0; j < 4; ++j) {
                    o0[j] = bias[j] + w[0][j] * xr[q][j] + w[1][j] * xr[q + 1][j] + w[2][j] * xr[q + 2][j] + w[3][j] * xr[q + 3][j];
                    o1[j] = bias[4 + j] + w[0][4 + j] * xr[q][4 + j] + w[1][4 + j] * xr[q + 1][4 + j] + w[2][4 + j] * xr[q + 2][4 + j] + w[3][4 + j] * xr[q + 3][4 + j]; }
                *(LAS f32x4*)(XC + (4 * tq + q) * 132 + cg8 * 8) = o0; *(LAS f32x4*)(XC + (4 * tq + q) * 132 + cg8 * 8 + 4) = o1; }
        }
        __syncthreads();
        f32x4 bval[8];
        const int cl = 16 * wid + 4 * fq;
        {
            const bf16_t* Wg = (const bf16_t*)(a.ws + OFF_WRG) + (size_t)(k2 * 8 + h) * 256 * 128;
            bf16x8 bfr[2][4];
#pragma unroll
            for (int wh = 0; wh < 2; ++wh)
#pragma unroll
                for (int ks = 0; ks < 4; ++ks) bfr[wh][ks] = *(const bf16x8*)(Wg + (size_t)(wh * 128 + 16 * wid + fr) * 128 + 32 * ks + 8 * fq);
            const int c = k2 * D + h * 128 + cl;
            const f32x4 ba = *(const f32x4*)(a.rg_b_a + c) * -1.4426950408889634f, bx = *(const f32x4*)(a.rg_b_x + c) * -1.4426950408889634f, nsp = *(const f32x4*)((const float*)(a.ws + OFF_NSP) + c);
#pragma unroll
            for (int mb = 0; mb < 8; ++mb) {
                f32x4 accR = (f32x4){0.f, 0.f, 0.f, 0.f}, accI = accR;
                {
                    const LAS float* p = XC + (16 * mb + fr) * 132 + 8 * fq; f32x4 v[8];
                    asm volatile("ds_read_b128 %0, %8\n\tds_read_b128 %1, %8 offset:16\n\tds_read_b128 %2, %8 offset:128\n\tds_read_b128 %3, %8 offset:144\n\t"
                                 "ds_read_b128 %4, %8 offset:256\n\tds_read_b128 %5, %8 offset:272\n\tds_read_b128 %6, %8 offset:384\n\tds_read_b128 %7, %8 offset:400\n\ts_waitcnt lgkmcnt(0)"
                                 : "=&v"(v[0]), "=&v"(v[1]), "=&v"(v[2]), "=&v"(v[3]), "=&v"(v[4]), "=&v"(v[5]), "=&v"(v[6]), "=&v"(v[7]) : "v"(p) : "memory");
#pragma unroll
                    for (int ks = 0; ks < 4; ++ks) { const u32x4 pk = pack8(v[2 * ks], v[2 * ks + 1]); const bf16x8 af = __builtin_bit_cast(bf16x8, pk);
                        accR = __builtin_amdgcn_mfma_f32_16x16x32_bf16(bfr[0][ks], af, accR, 0, 0, 0); accI = __builtin_amdgcn_mfma_f32_16x16x32_bf16(bfr[1][ks], af, accI, 0, 0, 0); } }
                const int t = 16 * mb + fr; const f32x4 xc = *(const LAS f32x4*)(XC + t * 132 + cl); f32x4 av;
#pragma unroll
                for (int j = 0; j < 4; ++j) {
                    const float er = __builtin_amdgcn_exp2f(fminf(fmaf(accR[j], -1.4426950408889634f, ba[j]), 57.7f)), ei = __builtin_amdgcn_exp2f(fminf(fmaf(accI[j], -1.4426950408889634f, bx[j]), 57.7f));
                    const float dr = 1.0f + er, di = 1.0f + ei, q = __builtin_amdgcn_rcpf(dr * di);
                    const float r = q * di, ig = q * dr, la = nsp[j] * r;
                    const float aa = __builtin_amdgcn_exp2f(la); av[j] = aa; bval[mb][j] = __builtin_amdgcn_sqrtf(fmaxf(1.0f - aa * aa, 0.f)) * (ig * xc[j]); }
                *(LAS f32x4*)(SA + t * 132 + cl) = av;
            }
        }
        __syncthreads();
#pragma unroll
        for (int mb = 0; mb < 8; ++mb) *(LAS f32x4*)(XC + (16 * mb + fr) * 132 + cl) = bval[mb];
        __syncthreads();
        if (h < 7) RG_PF_CONV(h + 1);
        {
            const int c = tid & 127, sg = tid >> 7;
            float P = 1.f, Hh = 0.f;
#pragma unroll 1
            for (int ib = 0; ib < 4; ++ib) {
                float av[8], bv[8];
#pragma unroll
                for (int i = 0; i < 8; ++i) { const int t = 32 * sg + 8 * ib + i; av[i] = SA[t * 132 + c]; bv[i] = XC[t * 132 + c]; }
#pragma unroll
                for (int i = 0; i < 8; ++i) { Hh = av[i] * Hh + bv[i]; P *= av[i]; bv[i] = Hh; av[i] = P; }
#pragma unroll
                for (int i = 0; i < 8; ++i) { const int t = 32 * sg + 8 * ib + i; XC[t * 132 + c] = bv[i]; SA[t * 132 + c] = av[i]; }
            }
            SEG[(sg * 128 + c) * 2] = P; SEG[(sg * 128 + c) * 2 + 1] = Hh;
        }
        __syncthreads();
        {
            const int cg8 = tid & 15, tq = tid >> 4;
            float Ain[8], Hin[8];
#pragma unroll
            for (int j = 0; j < 8; ++j) { Ain[j] = 1.f; Hin[j] = 0.f; }
#pragma unroll
            for (int i = 0; i < 4; ++i) { const int t = tq + 32 * i; const size_t cb2 = (size_t)(h * 128 + cg8 * 8) * 2;
                const LAS float* p = XC + t * 132 + cg8 * 8; const LAS float* q = SA + t * 132 + cg8 * 8;
                const f32x4 h0 = *(const LAS f32x4*)p, h1 = *(const LAS f32x4*)(p + 4), p0 = *(const LAS f32x4*)q, p1 = *(const LAS f32x4*)(q + 4);
                f32x4 ho0, ho1, po0, po1;
#pragma unroll
                for (int j = 0; j < 4; ++j) { ho0[j] = h0[j] + p0[j] * Hin[j]; po0[j] = p0[j] * Ain[j]; ho1[j] = h1[j] + p1[j] * Hin[4 + j]; po1[j] = p1[j] * Ain[4 + j]; }
                *(u32x4*)(AB + act_off(t0 + t, 2048, (size_t)16 << 20) + cb2) = pack8(ho0, ho1);
                *(u32x4*)(AB + act_off(t0 + t, 2048, (size_t)24 << 20) + cb2) = pack8(po0, po1);
#pragma unroll
                for (int j2 = 0; j2 < 4; ++j2) { const f32x4 sv = *(const LAS f32x4*)(SEG + (i * 128 + cg8 * 8 + 2 * j2) * 2);
                    Hin[2 * j2] = sv[0] * Hin[2 * j2] + sv[1]; Ain[2 * j2] *= sv[0]; Hin[2 * j2 + 1] = sv[2] * Hin[2 * j2 + 1] + sv[3]; Ain[2 * j2 + 1] *= sv[2]; } }
            if (tq == 0) {
#pragma unroll
                for (int j = 0; j < 8; ++j) { CHA[(size_t)ch * D + h * 128 + cg8 * 8 + j] = Ain[j]; CHH[(size_t)ch * D + h * 128 + cg8 * 8 + j] = Hin[j]; } }
        }
        __syncthreads();
      }
#undef RG_PF_CONV
    }
}

__device__ __forceinline__ void rg_out_phase(const Args& a, int vb, LAS unsigned char* lds) {
    int tid_ = threadIdx.x; asm volatile("" : "+v"(tid_)); const int tid = tid_;
    LAS float* CAR = (LAS float*)lds;
    unsigned char* AB = a.ws + OFF_ACT;
    const float* CHA = (const float*)(a.ws + OFF_CHA); const float* CHH = (const float*)(a.ws + OFF_CHH);
    for (int ch = vb; ch < 256; ch += gridDim.x) {
        const int firstc = ch & ~127, t0 = ch * 128;
        {
            const int q = tid & 255, hv = tid >> 8, n = ch - firstc, nlo = n >> 1, jb = firstc + (hv ? nlo : 0), je = hv ? ch : firstc + nlo;
            f32x4 Aa = (f32x4){1.f, 1.f, 1.f, 1.f}, Hh = (f32x4){0.f, 0.f, 0.f, 0.f};
#pragma unroll 8
            for (int j = jb; j < je; ++j) { const f32x4 av = *(const f32x4*)(CHA + (size_t)j * D + 4 * q), hv4 = *(const f32x4*)(CHH + (size_t)j * D + 4 * q); Hh = av * Hh + hv4; Aa = Aa * av; }
            LAS f32x4* TMP = (LAS f32x4*)(CAR + 1024);
            if (hv) { TMP[q * 2] = Aa; TMP[q * 2 + 1] = Hh; }
            __syncthreads();
            if (!hv) { const f32x4 A2 = TMP[q * 2], H2 = TMP[q * 2 + 1]; *(LAS f32x4*)(CAR + 4 * q) = A2 * Hh + H2; }
        }
        __syncthreads();
        const int cg8 = tid & 127; const f32x4 ca = *(const LAS f32x4*)(CAR + cg8 * 8), cb = *(const LAS f32x4*)(CAR + cg8 * 8 + 4);
        const float car[8] = {ca[0], ca[1], ca[2], ca[3], cb[0], cb[1], cb[2], cb[3]};
        const size_t cb2 = (size_t)cg8 * 16;
#pragma unroll 1
        for (int ib = 0; ib < 8; ++ib) {
            u32x4 qh[4], qa[4], qg[4];
#pragma unroll
            for (int k = 0; k < 4; ++k) { const int t = (tid >> 7) + 4 * (4 * ib + k);
                qh[k] = *(const u32x4*)(AB + act_off(t0 + t, 2048, (size_t)16 << 20) + cb2); qa[k] = *(const u32x4*)(AB + act_off(t0 + t, 2048, (size_t)24 << 20) + cb2);
                qg[k] = *(const u32x4*)(AB + act_off(t0 + t, 2048, (size_t)8 << 20) + cb2); }
#pragma unroll
            for (int k = 0; k < 4; ++k) { const int t = (tid >> 7) + 4 * (4 * ib + k);
                float hl[8], ap[8], gb[8]; unpack8(qh[k], hl); unpack8(qa[k], ap); unpack8(qg[k], gb);
                f32x4 y0, y1;
#pragma unroll
                for (int j = 0; j < 4; ++j) { y0[j] = (hl[j] + ap[j] * car[j]) * gelu_t(gb[j]); y1[j] = (hl[4 + j] + ap[4 + j] * car[4 + j]) * gelu_t(gb[4 + j]); }
                *(u32x4*)(AB + act_off(t0 + t, 2048, (size_t)8 << 20) + cb2) = pack8(y0, y1); }
        }
        __syncthreads();
    }
}

__device__ __forceinline__ void gm_gate_phase(const Args& a, int vb, int k2, LAS unsigned char* lds) {
    int tid_ = threadIdx.x; asm volatile("" : "+v"(tid_)); const int tid = tid_, wid = tid >> 6, lane = tid & 63, fr = lane & 15, fq = lane >> 4;
    constexpr int VS = 272, AS = 136;
    LAS bf16_t* VT = (LAS bf16_t*)lds;
    LAS bf16_t* AW = VT + 128 * VS;
    LAS float* MU = (LAS float*)(AW + 128 * AS); LAS float* RSTD = MU + 128; LAS float* C1 = RSTD + 128; LAS float* C2S = C1 + 128; LAS float* BSS = C2S + 128;
    unsigned char* AB = a.ws + OFF_ACT;
    const float* VSTAT = (const float*)(a.ws + OFF_VSTAT); const float* C2 = (const float*)(a.ws + OFF_C2);
    const bf16_t* WGS = (const bf16_t*)(a.ws + OFF_WGS);
    for (int ch = vb; ch < 256; ch += gridDim.x) {
        const int t0 = ch * 128;
        u32x4 vq[8], wq4[4];
        { const bf16_t* wp0 = WGS + ((size_t)(k2 * 8 + 0) * 128 + (tid >> 2)) * 128 + 32 * (tid & 3);
#pragma unroll
          for (int p = 0; p < 4; ++p) wq4[p] = *(const u32x4*)(wp0 + 8 * p); }
#pragma unroll
        for (int i = 0; i < 8; ++i) { const int item = tid + 512 * i, row = item >> 5, c16 = item & 31; vq[i] = *(const u32x4*)(AB + act_off(t0 + row, 4096, (size_t)16 << 20) + (size_t)c16 * 16); }
        if (tid < 128) { const float* p = VSTAT + (size_t)(t0 + tid) * 64; float s = 0.f, q = 0.f;
#pragma unroll
            for (int i = 0; i < 16; ++i) { const f32x4 v = *(const f32x4*)(p + 4 * i); s += v[0] + v[2]; q += v[1] + v[3]; }
            const float mu = s * (1.0f / 2048.0f), var = fmaxf(q * (1.0f / 2048.0f) - mu * mu, 0.f); MU[tid] = mu; RSTD[tid] = rsqrtf(var + EPS); }
        __syncthreads();
        for (int g = 0; g < 8; ++g) {
            const int d0 = g * 256 + 32 * wid + 8 * fq;
            u32x4 uq[8];
#pragma unroll
            for (int mb = 0; mb < 8; ++mb)
                uq[mb] = *(const u32x4*)(AB + act_off(t0 + 16 * mb + fr, 4096, 0) + (size_t)d0 * 2);
            {
                const int t = tid >> 2, sq = tid & 3; float c1 = 0.f;
                if (tid < 128) { C2S[tid] = C2[(k2 * 8 + g) * 128 + tid]; BSS[tid] = a.gm_b_s[(size_t)(k2 * 8 + g) * 128 + tid]; }
#pragma unroll
                for (int p = 0; p < 4; ++p) { float f[8]; unpack8(wq4[p], f); f32x4 f0, f1;
#pragma unroll
                    for (int j = 0; j < 4; ++j) { f0[j] = f[j] * RSTD[32 * sq + 8 * p + j]; f1[j] = f[4 + j] * RSTD[32 * sq + 8 * p + 4 + j]; }
                    const u32x4 pk = pack8(f0, f1); float fr8[8]; unpack8(pk, fr8);
#pragma unroll
                    for (int j = 0; j < 8; ++j) c1 += fr8[j] * MU[32 * sq + 8 * p + j];
                    *(LAS u32x4*)(AW + t * AS + 32 * sq + 8 * p) = pk; }
                c1 += __shfl_xor(c1, 1); c1 += __shfl_xor(c1, 2);
                if (sq == 0) C1[t] = c1;
            }
            {
#pragma unroll
                for (int i = 0; i < 8; ++i) { const int item = tid + 512 * i, row = item >> 5, c16 = item & 31; const u32x4 q = vq[i];
                    LAS u32x2* dp = (LAS u32x2*)(VT + row * VS + 8 * c16); dp[0] = (u32x2){q.x, q.y}; dp[1] = (u32x2){q.z, q.w}; }
            }
            __syncthreads();
            if (g < 7) {
                { const bf16_t* wpn = WGS + ((size_t)(k2 * 8 + g + 1) * 128 + (tid >> 2)) * 128 + 32 * (tid & 3);
#pragma unroll
                  for (int p = 0; p < 4; ++p) wq4[p] = *(const u32x4*)(wpn + 8 * p); }
#pragma unroll
                for (int i = 0; i < 8; ++i) { const int item = tid + 512 * i, row = item >> 5, c16 = item & 31; vq[i] = *(const u32x4*)(AB + act_off(t0 + row, 4096, (size_t)16 << 20) + (size_t)((g + 1) * 256 + 8 * c16) * 2); } }
            f32x4 gd[2], bd[2];
#pragma unroll
            for (int nb = 0; nb < 2; ++nb) { gd[nb] = *(const f32x4*)(a.gm_ln_g + (size_t)k2 * 2048 + d0 + 4 * nb); bd[nb] = *(const f32x4*)(a.gm_ln_b + (size_t)k2 * 2048 + d0 + 4 * nb); }
#pragma unroll 1
            for (int hf = 0; hf < 2; ++hf) {
                float c2t[4], bst[4];
#pragma unroll
                for (int ml = 0; ml < 4; ++ml) { const int t = 64 * hf + 16 * ml + fr;
                    c2t[ml] = C2S[t]; bst[ml] = BSS[t];
                }
                f32x4 acc[4][2];
#pragma unroll
                for (int ml = 0; ml < 4; ++ml) { acc[ml][0] = (f32x4){0.f, 0.f, 0.f, 0.f}; acc[ml][1] = acc[ml][0]; }
#pragma unroll 1
                for (int ks = 0; ks < 2 * hf + 2; ++ks) {
                    bf16x8 vf[2];
                    {
                        const LAS bf16_t* vp = VT + (32 * ks + 8 * fq + ((lane & 15) >> 2)) * VS + 32 * wid + 8 * (lane & 3);
                        u32x2 r00, r01, r10, r11;
                        asm volatile("ds_read_b64_tr_b16 %0, %4\n\tds_read_b64_tr_b16 %1, %4 offset:2176\n\tds_read_b64_tr_b16 %2, %4 offset:8\n\tds_read_b64_tr_b16 %3, %4 offset:2184\n\ts_waitcnt lgkmcnt(0)"
                                     : "=&v"(r00), "=&v"(r01), "=&v"(r10), "=&v"(r11) : "v"(vp) : "memory");
                        vf[0] = __builtin_bit_cast(bf16x8, (u32x4){r00.x, r00.y, r01.x, r01.y});
                        vf[1] = __builtin_bit_cast(bf16x8, (u32x4){r10.x, r10.y, r11.x, r11.y}); }
                    bf16x8 af4[4];
                    {   const LAS bf16_t* ap = AW + (64 * hf + fr) * AS + 32 * ks + 8 * fq;
                        asm volatile("ds_read_b128 %0, %4\n\tds_read_b128 %1, %4 offset:4352\n\tds_read_b128 %2, %4 offset:8704\n\tds_read_b128 %3, %4 offset:13056\n\ts_waitcnt lgkmcnt(0)"
                                     : "=&v"(af4[0]), "=&v"(af4[1]), "=&v"(af4[2]), "=&v"(af4[3]) : "v"(ap) : "memory"); }
#pragma unroll
                    for (int ml = 0; ml < 4; ++ml) if (64 * hf + 16 * ml + 15 >= 32 * ks) {
                        acc[ml][0] = __builtin_amdgcn_mfma_f32_16x16x32_bf16(vf[0], af4[ml], acc[ml][0], 0, 0, 0);
                        acc[ml][1] = __builtin_amdgcn_mfma_f32_16x16x32_bf16(vf[1], af4[ml], acc[ml][1], 0, 0, 0); }
                }
#pragma unroll
                for (int ml = 0; ml < 4; ++ml) { const int t = 64 * hf + 16 * ml + fr; const float c1t = C1[t];
                    const u32x4 uw = hf ? uq[4 + ml] : uq[ml];
                    const f32x4 u0 = (f32x4){bf_lo(uw.x), bf_hi(uw.x), bf_lo(uw.y), bf_hi(uw.y)}, u1 = (f32x4){bf_lo(uw.z), bf_hi(uw.z), bf_lo(uw.w), bf_hi(uw.w)};
                    const f32x4 y0 = u0 * (gd[0] * (acc[ml][0] - c1t) + bd[0] * c2t[ml] + bst[ml]), y1 = u1 * (gd[1] * (acc[ml][1] - c1t) + bd[1] * c2t[ml] + bst[ml]);
                    *(u32x4*)(AB + act_off(t0 + t, 4096, 0) + (size_t)d0 * 2) = pack8(y0, y1); }
            }
            __syncthreads();
        }
    }
}

template <class Epi> __device__ __forceinline__ void run_gemm(LAS unsigned char* lds, int c, const bf16_t* A, size_t ars, const bf16_t* Bt, int N, int K, const Epi& E) {
    StaticOrder S; S.init(T, N, (int)gridDim.x, c);
    Gemm g; g.A = A; g.Bt = Bt; g.M = T; g.N = N; g.K = K; g.ars = ars;
    gemm_phase<Epi, StaticOrder, false>(lds, g, S, E, nullptr);
}

__global__ void __launch_bounds__(512) fwd_megakernel(Args a) {
    extern __shared__ __attribute__((aligned(16))) unsigned char shm[];
    LAS unsigned char* lds = (LAS unsigned char*)shm;
    cg::grid_group grid = cg::this_grid();
#ifdef TPROBE
    const unsigned long long tkstart = __builtin_amdgcn_s_memrealtime();
#endif
    volatile LAS unsigned* xst = (volatile LAS unsigned*)(lds + LDS_BYTES - 16);
    unsigned* LOC = (unsigned*)(a.ws + OFF_LOC);
    const unsigned myx = xb_xcc_id() & 7u;
    if (threadIdx.x == 0) { xst[0] = 0u; xst[1] = 0u; xst[2] = xb_add(LOC + 64 * myx, 1u); }
    __syncthreads();
    const XcdBarrier xb = xcd_barrier_post((unsigned*)(a.ws + OFF_BAR), xst);
    const unsigned myr = xst[2];
    bf16_t* H = (bf16_t*)(a.ws + OFF_H); bf16_t* O = (bf16_t*)(a.ws + OFF_O); bf16_t* ACT = (bf16_t*)(a.ws + OFF_ACT);
    float* SSQ = (float*)(a.ws + OFF_SSQ);

    prep_phase(a, lds);
    if (a.ws == nullptr) grid.sync();
    xcd_barrier(xb);
#ifdef FORCE_FALLBACK
    bool okl = false;
#else
    bool okl = (gridDim.x == 256);
#endif
#pragma unroll
    for (int x = 0; x < 8; ++x) okl = okl && (xb_ld(LOC + 64 * x) == 32u);
    const int vb = okl ? (int)(myx * 32u + myr) : (int)blockIdx.x;
    const int cg_ = okl ? (int)(myr * 8u + myx) : (int)blockIdx.x;
    unsigned* lcnt = LOC + 64 * (8 + myx);
#ifdef TPROBE
    unsigned long long tacc = 0ull, tprev = __builtin_amdgcn_s_memrealtime(); int tcur = 1; if (TPROBE == 3) tacc = tprev - tkstart;
#define TCAT(c) tcur = (c)
#define TSTAMP() do { const unsigned long long t_ = __builtin_amdgcn_s_memrealtime(); if (tcur == TPROBE) tacc += t_ - tprev; tprev = t_; } while (0)
#define GSYNC() do { xcd_barrier(xb); TSTAMP(); } while (0)
#else
#define TCAT(c)
#define TSTAMP()
#define GSYNC() xcd_barrier(xb)
#endif
#define LSYNC() do { if (okl) xcc_local_barrier(lcnt, 32u); else xcd_barrier(xb); TSTAMP(); } while (0)
    const size_t ARS_H = (size_t)4096 * D * 2;

    TCAT(1); ew_phase(a, vb, -1, 0, 0, a.x, a.out, H);
    LSYNC();
    for (int si = 0; si < 12; ++si) {
        const int l = si / 3, j = si % 3, k2 = l >> 1;
        const int type = (j != 1) ? 0 : ((l & 1) ? 2 : 1);
        const bf16_t* A2; const bf16_t* B2; int K2;
        if (type == 0) {
            const int fi = l * 2 + (j >> 1);
            EpiSwiglu e; e.O = ACT; TCAT(0);
            run_gemm(lds, cg_, H, ARS_H, (const bf16_t*)(a.ws + OFF_WFI) + (size_t)fi * 5632 * 1024, 5632, 1024, e);
            A2 = ACT; B2 = (const bf16_t*)(a.ws + OFF_WFO) + (size_t)fi * 1024 * 2816; K2 = 2816;
            LSYNC();
        } else if (type == 1) {
            TCAT(0); EpiSplit<0> e; e.O0 = ACT; e.O1 = nullptr; e.half = 1024; e.vstat = nullptr;
            run_gemm(lds, cg_, H, ARS_H, (const bf16_t*)(a.ws + OFF_WRI) + (size_t)k2 * 2048 * 1024, 2048, 1024, e);
            GSYNC();
            TCAT(2); rg_scan_phase(a, vb, k2, lds);
            GSYNC();
#ifdef SKEW_ITERS
            if (okl && myx >= 4u) { for (int i_ = 0; i_ < SKEW_ITERS; ++i_) __builtin_amdgcn_s_sleep(127); }
#endif
            TCAT(5); rg_out_phase(a, vb, lds);
            A2 = (const bf16_t*)((const unsigned char*)ACT + ((size_t)8 << 20)); B2 = (const bf16_t*)(a.ws + OFF_WRO) + (size_t)k2 * 1024 * 1024; K2 = 1024;
            LSYNC();
        } else {
            TCAT(0); EpiSplit<1> e; e.O0 = ACT; e.O1 = nullptr; e.half = 2048; e.vstat = (float*)(a.ws + OFF_VSTAT);
            run_gemm(lds, cg_, H, ARS_H, (const bf16_t*)(a.ws + OFF_WGI) + (size_t)k2 * 4096 * 1024, 4096, 1024, e);
            LSYNC();
            TCAT(6); gm_gate_phase(a, vb, k2, lds);
            A2 = ACT; B2 = (const bf16_t*)(a.ws + OFF_WGO) + (size_t)k2 * 1024 * 2048; K2 = 2048;
            LSYNC();
        }
        TCAT(0);
        { EpiOutSsq e; e.O = (si & 1) ? (bf16_t*)(a.ws + OFF_O2) : O; e.ssq = (si & 1) ? (float*)(a.ws + OFF_SSQ2) : SSQ; run_gemm(lds, cg_, A2, REGB, B2, 1024, K2, e); }
        LSYNC();
        TCAT(1); ew_phase(a, vb, si, si < 11 ? si + 1 : -1, (si & 1) ? 2 : 1, si <= 1 ? a.x : a.out, a.out, H);
        LSYNC();
    }
#ifdef TPROBE
    {
        float* TM = (float*)(a.ws + OFF_C2);
        if (vb == 0 && threadIdx.x == 0) TM[0] = (float)tacc * 0.01f * TSCALE;
        xcd_barrier(xb);
        const float eps_ = TM[0];
        for (int r = 0; r < 128; ++r) { float* p = a.out + (size_t)(vb * 128 + r) * D; for (int c_ = threadIdx.x; c_ < D; c_ += 512) p[c_] *= (1.0f + eps_); }
    }
#endif
}

extern "C" void kernel_launch(void* const* d_in, const int* in_sizes, int n_in, void* d_out, int out_size, void* d_ws, size_t ws_size, hipStream_t stream) {
    static int grid_blocks = 0;
    if (grid_blocks == 0) {
        if (n_in != 23 || out_size != T * D || ws_size < WS_END) { fprintf(stderr, "kernel_launch: unexpected shapes (n_in %d out %d ws %zu need %zu)\n", n_in, out_size, ws_size, (size_t)WS_END); grid_blocks = -1; return; }
        int dev = 0, cus = 0, per_cu = 0;
        hipGetDevice(&dev);
        hipDeviceGetAttribute(&cus, hipDeviceAttributeMultiprocessorCount, dev);
        if (hipFuncSetAttribute((const void*)fwd_megakernel, hipFuncAttributeMaxDynamicSharedMemorySize, LDS_BYTES) != hipSuccess) { fprintf(stderr, "kernel_launch: hipFuncSetAttribute failed\n"); (void)hipGetLastError(); }
        if (hipOccupancyMaxActiveBlocksPerMultiprocessor(&per_cu, (const void*)fwd_megakernel, 512, LDS_BYTES) != hipSuccess || per_cu < 1) { fprintf(stderr, "kernel_launch: occupancy query gave %d\n", per_cu); (void)hipGetLastError(); per_cu = 1; }
        grid_blocks = cus * 1;
        if (grid_blocks <= 0) grid_blocks = 256;
    }
    if (grid_blocks < 0) return;
    Args a{};
    const float** ap = (const float**)&a;
    for (int i = 0; i < 23; ++i) ap[i] = (const float*)d_in[i];
    a.out = (float*)d_out; a.ws = (unsigned char*)d_ws;
    if (hipMemsetAsync((unsigned char*)d_ws + OFF_BAR, 0, WS_END - OFF_BAR, stream) != hipSuccess) { fprintf(stderr, "kernel_launch: memset failed\n"); return; }
    void* args[] = {&a};
    hipError_t e = hipLaunchCooperativeKernel((const void*)fwd_megakernel, dim3(grid_blocks), dim3(512), args, LDS_BYTES, stream);
    if (e != hipSuccess) fprintf(stderr, "cooperative launch failed: %s (grid %d)\n", hipGetErrorString(e), grid_blocks);
}
```

```cpp
#include <hip/hip_runtime.h>
#include <hip/hip_cooperative_groups.h>
#include <cstdio>
namespace cg = cooperative_groups;
namespace pg8 {
#define PG8_LAS __attribute__((address_space(3)))
typedef unsigned short bf16_t;
typedef short bf16x8 __attribute__((ext_vector_type(8)));
typedef float f32x4 __attribute__((ext_vector_type(4)));
typedef unsigned u32x4 __attribute__((ext_vector_type(4)));
constexpr int BM = 256, BK = 64, HALF = 128, HTB = HALF * BK * 2  , STAGE_BYTES = 8 * HTB, NXCD = 8, WGM = 8;

__host__ __device__ __forceinline__ int lds_byte(int r, int c) { const int st = (r >> 4) * 2 + (c >> 5), rr = r & 15, cc = c & 31, ob = rr * 64 + cc * 2; return st * 1024 + (ob ^ (((ob >> 9) & 1) << 5)); }
__host__ __device__ __forceinline__ void stage_rc(int b, int& R, int& C) { const int st = b / 1024, sb = b % 1024, swz = sb ^ (((sb >> 9) & 1) << 5); R = (st >> 1) * 16 + swz / 64; C = (st & 1) * 32 + (swz % 64) / 2; }
__host__ __device__ __forceinline__ int perm32(int rho) { const int n = rho >> 4, i = rho & 15; return 8 * (i >> 2) + 4 * n + (i & 3); }

struct Unit { int pm, pn; };
struct Gemm { const bf16_t* A; const bf16_t* Bt; int M, N, K; size_t ars; };

struct StaticOrder {
    int nM, nN, nwg, G, c;
    __host__ __device__ void init(int M, int N, int G_, int c_) { nM = M / BM; nN = N / BM; nwg = nM * nN; G = G_; c = c_; }
    __host__ __device__ bool next(int i, Unit& u) const {
        const long L = (long)i * G + c; if (L >= nwg) return false;
        int wgid = (int)L; { const int q = nwg / NXCD, r = nwg % NXCD, xcd = wgid % NXCD, off = wgid / NXCD; wgid = (xcd < r ? xcd * (q + 1) : r * (q + 1) + (xcd - r) * q) + off; }
        const int nig = WGM * nN, gid = wgid / nig, fm = gid * WGM, gsz = (nM - fm) < WGM ? (nM - fm) : WGM;
        u.pm = fm + ((wgid % nig) % gsz); u.pn = (wgid % nig) / gsz; return true;
    }
    __device__ __forceinline__ void a_ready(const Unit&) const {}
    __device__ __forceinline__ void done(const Unit&) const {}
};
__device__ __forceinline__ unsigned cvt_pk_bf16(float lo, float hi) { unsigned r; asm volatile("v_cvt_pk_bf16_f32 %0, %1, %2" : "=v"(r) : "v"(lo), "v"(hi)); return r; }
template <class Epi, class Sched, bool STAMP = false>
__device__ __forceinline__ void gemm_phase(PG8_LAS unsigned char* lds, const Gemm g, const Sched& S, const Epi& E, unsigned long long* stamps) {
    int tid_ = threadIdx.x; asm volatile("" : "+v"(tid_)); const int tid = tid_, wid = __builtin_amdgcn_readfirstlane(tid >> 6), lane = tid & 63, wr = wid >> 2, wc = wid & 3, fr = lane & 15, fq = lane >> 4;
    const int K = g.K, nt = K / BK;
    int ts_lo = 0, ts_hi = 0, nts = 0; const unsigned long long rt_entry = STAMP ? (unsigned long long)wall_clock64() : 0ull;
#define PG8_STAMP() do { if (STAMP && wid == 0 && nts < 64) { const unsigned long long _c = (unsigned long long)clock64(); \
        ts_lo = (lane == nts) ? (int)(unsigned)_c : ts_lo; ts_hi = (lane == nts) ? (int)(unsigned)(_c >> 32) : ts_hi; ++nts; } } while (0)
    PG8_STAMP();
    unsigned voffA[2], voffB[2];
#pragma unroll
    for (int i = 0; i < 2; ++i) { int R, C; stage_rc(tid * 16 + i * 8192, R, C); const int Rb = Epi::PERM ? ((R & ~31) + perm32(R & 31)) : R;
        voffA[i] = (unsigned)(R * K + C) * 2u; voffB[i] = (unsigned)(Rb * K + C) * 2u; }
    const size_t kstep = (size_t)(BK * 2);
    const size_t hstep = (size_t)HALF * K * 2;
    const size_t tstep = 2 * hstep;
    const unsigned ldsw = (unsigned)wid * 1024u;
    const int aoff = lds_byte(wr * 64 + fr, fq * 8), boff = lds_byte(wc * 32 + fr, fq * 8);
#define PG8_SA(b, h) (((b) * 2 + (h)) * HTB)
#define PG8_SB(b, h) ((4 + (b) * 2 + (h)) * HTB)
#define PG8_STAGE(bufoff, gbase, voff) do { _Pragma("unroll") for (int _i = 0; _i < 2; ++_i) \
        __builtin_amdgcn_global_load_lds((const unsigned*)((const char*)(gbase) + (voff)[_i]), (PG8_LAS unsigned*)(lds + (bufoff) + ldsw + _i * 8192), 16, 0, 0); } while (0)
#define PG8_LDA(dst, b, h) do { _Pragma("unroll") for (int m = 0; m < 4; ++m) _Pragma("unroll") for (int k = 0; k < 2; ++k) dst[m][k] = *(const PG8_LAS bf16x8*)(lds + PG8_SA(b, h) + aoff + m * 2048 + k * 1024); } while (0)
#define PG8_LDB(dst, b, h) do { _Pragma("unroll") for (int n = 0; n < 2; ++n) _Pragma("unroll") for (int k = 0; k < 2; ++k) dst[n][k] = *(const PG8_LAS bf16x8*)(lds + PG8_SB(b, h) + boff + n * 2048 + k * 1024); } while (0)
#define PG8_MMA(ai, bj, At, Bt) do { __builtin_amdgcn_s_setprio(1); _Pragma("unroll") for (int m = 0; m < 4; ++m) _Pragma("unroll") for (int n = 0; n < 2; ++n) _Pragma("unroll") for (int k = 0; k < 2; ++k) \
        acc[ai][bj][m][n] = __builtin_amdgcn_mfma_f32_16x16x32_bf16(Bt[n][k], At[m][k], acc[ai][bj][m][n], 0, 0, 0); __builtin_amdgcn_s_setprio(0); } while (0)
#define PG8_WAIT_V(n) asm volatile("s_waitcnt vmcnt(" #n ")" ::: "memory")
#define PG8_WAIT_L(n) asm volatile("s_waitcnt lgkmcnt(" #n ")" ::: "memory")
#define PG8_BAR __builtin_amdgcn_s_barrier()
#define PG8_SCHED __builtin_amdgcn_sched_barrier(0)
    Unit cur, nxt; int ui = 0;
    if (!S.next(0, cur)) return;
    f32x4 acc[2][2][4][2];
#pragma unroll
    for (int a = 0; a < 2; ++a)
#pragma unroll
        for (int b = 0; b < 2; ++b)
#pragma unroll
            for (int m = 0; m < 4; ++m)
#pragma unroll
                for (int n = 0; n < 2; ++n) acc[a][b][m][n] = (f32x4){0.f, 0.f, 0.f, 0.f};
    bf16x8 At[4][2], B0[2][2], B1[2][2];
    const char* cA = (const char*)g.A + (size_t)(cur.pm >> 4) * g.ars + (size_t)(cur.pm & 15) * tstep; const char* cB = (const char*)g.Bt + (size_t)cur.pn * tstep;
    S.a_ready(cur);
    PG8_STAGE(PG8_SB(0, 0), cB, voffB); PG8_STAGE(PG8_SA(0, 0), cA, voffA); PG8_STAGE(PG8_SB(0, 1), cB + hstep, voffB); PG8_STAGE(PG8_SA(0, 1), cA + hstep, voffA);
    if (wr == 1) PG8_BAR;
    PG8_WAIT_V(4); PG8_BAR;
    PG8_STAGE(PG8_SB(1, 0), cB + kstep, voffB); PG8_STAGE(PG8_SA(1, 0), cA + kstep, voffA); PG8_STAGE(PG8_SB(1, 1), cB + hstep + kstep, voffB);
    PG8_WAIT_V(6); PG8_BAR;
    PG8_STAMP();
    for (;;) {
        const bool has_next = S.next(ui + 1, nxt);
        const char* nA = has_next ? (const char*)g.A + (size_t)(nxt.pm >> 4) * g.ars + (size_t)(nxt.pm & 15) * tstep : cA; const char* nB = has_next ? (const char*)g.Bt + (size_t)nxt.pn * tstep : cB;
        for (int t = 0; t < nt; t += 2) {
            const bool last = (t == nt - 2);
            const char* a1 = cA + (size_t)(t + 1) * kstep;
            const char* a2 = last ? nA : cA + (size_t)(t + 2) * kstep; const char* b2 = last ? nB : cB + (size_t)(t + 2) * kstep;
            const char* a3 = a2 + kstep; const char* b3 = b2 + kstep;
            if (last && has_next) S.a_ready(nxt);
            PG8_LDB(B0, 0, 0); PG8_SCHED; PG8_LDA(At, 0, 0); PG8_STAGE(PG8_SA(1, 1), a1 + hstep, voffA);
            PG8_WAIT_L(8); PG8_BAR; PG8_WAIT_L(0); PG8_MMA(0, 0, At, B0); PG8_BAR; PG8_SCHED;
            PG8_LDB(B1, 0, 1); PG8_STAGE(PG8_SB(0, 0), b2, voffB);
            PG8_BAR; PG8_WAIT_L(0); PG8_MMA(0, 1, At, B1); PG8_BAR;
            PG8_LDA(At, 0, 1); PG8_STAGE(PG8_SA(0, 0), a2, voffA);
            PG8_BAR; PG8_WAIT_L(0); PG8_MMA(1, 0, At, B0); PG8_BAR; PG8_SCHED;
            PG8_STAGE(PG8_SB(0, 1), b2 + hstep, voffB);
            PG8_WAIT_V(6); PG8_BAR; PG8_MMA(1, 1, At, B1); PG8_BAR;
            PG8_LDB(B0, 1, 0); PG8_SCHED; PG8_LDA(At, 1, 0); PG8_STAGE(PG8_SA(0, 1), a2 + hstep, voffA);
            PG8_WAIT_L(8); PG8_BAR; PG8_WAIT_L(0); PG8_MMA(0, 0, At, B0); PG8_BAR; PG8_SCHED;
            PG8_LDB(B1, 1, 1); PG8_STAGE(PG8_SB(1, 0), b3, voffB);
            PG8_BAR; PG8_WAIT_L(0); PG8_MMA(0, 1, At, B1); PG8_BAR;
            PG8_LDA(At, 1, 1); PG8_STAGE(PG8_SA(1, 0), a3, voffA);
            PG8_BAR; PG8_WAIT_L(0); PG8_MMA(1, 0, At, B0); PG8_BAR; PG8_SCHED;
            PG8_STAGE(PG8_SB(1, 1), b3 + hstep, voffB);
            PG8_WAIT_V(6); PG8_BAR; PG8_MMA(1, 1, At, B1); PG8_BAR;
        }
        PG8_STAMP();
        if constexpr (!Epi::AFTER_DRAIN) { E(acc, cur, wr, wc, fr, fq); S.done(cur); }
        PG8_STAMP();
        if (!has_next) break;
#pragma unroll
        for (int a = 0; a < 2; ++a)
#pragma unroll
            for (int b = 0; b < 2; ++b)
#pragma unroll
                for (int m = 0; m < 4; ++m)
#pragma unroll
                    for (int n = 0; n < 2; ++n) acc[a][b][m][n] = (f32x4){0.f, 0.f, 0.f, 0.f};
        cur = nxt; cA = nA; cB = nB; ++ui;
    }
    PG8_WAIT_V(0);
    if (wr == 0) PG8_BAR;
    PG8_BAR;
    if constexpr (Epi::AFTER_DRAIN) { E.fused(acc, cur, wr, wc, fr, fq, lds, wid, lane); S.done(cur); }
    PG8_STAMP();
    if (STAMP && wid == 0) { stamps[lane] = lane < nts ? (((unsigned long long)(unsigned)ts_hi << 32) | (unsigned)ts_lo) : 0ull;
        if (lane == 62) stamps[62] = rt_entry; if (lane == 63) stamps[63] = (unsigned long long)wall_clock64(); }
#undef PG8_STAMP
#undef PG8_SA
#undef PG8_SB
#undef PG8_STAGE
#undef PG8_LDA
#undef PG8_LDB
#undef PG8_MMA
#undef PG8_WAIT_V
#undef PG8_WAIT_L
#undef PG8_BAR
#undef PG8_SCHED
}
}
#define LAS PG8_LAS
#define XB_TMO      128
#define XB_XCNT(j)  (256  + 64 * (j))
#define XB_XSUB(j)  (1280 + 64 * (j))
#define XB_XGEN(j)  (2304 + 64 * (j))
#define XB_TOP      3328
#define XB_TOPGEN   3392
#define XCD_BAR_WORDS 3456
#define XB_SPIN_CAP (1u << 18)

__device__ __forceinline__ unsigned xb_ld(unsigned* p)              { return __hip_atomic_load(p, __ATOMIC_RELAXED, __HIP_MEMORY_SCOPE_AGENT); }
__device__ __forceinline__ unsigned xb_add(unsigned* p, unsigned v) { return __hip_atomic_fetch_add(p, v, __ATOMIC_RELAXED, __HIP_MEMORY_SCOPE_AGENT); }
__device__ __forceinline__ unsigned xb_xcc_id() { return (unsigned)__builtin_amdgcn_s_getreg((3 << 11) | 20) & 0xFu; }
#define XB_SPIN(cond, bar) do { unsigned _sp = 0; while (cond) { __builtin_amdgcn_s_sleep(1); \
    if ((++_sp & 255u) == 0u) { if (xb_ld(&(bar)[XB_TMO])) break; if (_sp > XB_SPIN_CAP) { atomicAdd(&(bar)[XB_TMO], 1u); break; } } } } while (0)

struct XcdBarrier {
    unsigned* bar; unsigned x;
    volatile LAS unsigned* st;
};

__device__ __forceinline__ XcdBarrier xcd_barrier_post(unsigned* bar, volatile LAS unsigned* st) {
    XcdBarrier b; b.bar = bar; b.x = xb_xcc_id(); b.st = st;
    if (threadIdx.x == 0) (void)xb_add(&bar[XB_XCNT(b.x)], 1u);
    return b;
}
__device__ __forceinline__ void xcd_barrier_complete(unsigned* bar, unsigned x, unsigned& nloc, unsigned& nx) {
    const unsigned G = gridDim.x * gridDim.y * gridDim.z;
    unsigned sum, cnt, mine, sp = 0u;
    for (;;) {
        sum = 0u; cnt = 0u; mine = 0u;
#pragma unroll
        for (unsigned j = 0; j < 16; ++j) { const unsigned c = xb_ld(&bar[XB_XCNT(j)]); sum += c; cnt += (c > 0u) ? 1u : 0u; mine = (j == x) ? c : mine; }
        if (sum == G) break;
        __builtin_amdgcn_s_sleep(1);
        if ((++sp & 255u) == 0u) { if (xb_ld(&bar[XB_TMO])) break; if (sp > XB_SPIN_CAP) { atomicAdd(&bar[XB_TMO], 1u); break; } }
    }
    nloc = mine > 0u ? mine : 1u; nx = cnt > 0u ? cnt : 1u;
}

__device__ __forceinline__ void xcd_barrier(const XcdBarrier& b) {
    asm volatile("s_waitcnt vmcnt(0)" ::: "memory");
    __syncthreads();
    if (threadIdx.x == 0) {
        unsigned* bar = b.bar;
        __builtin_amdgcn_s_waitcnt(0);
        unsigned nloc = b.st[0], nx = b.st[1];
        if (nloc == 0u) { xcd_barrier_complete(bar, b.x, nloc, nx); b.st[0] = nloc; b.st[1] = nx; }
        const unsigned old = xb_add(&bar[XB_XSUB(b.x)], 1u);
        const unsigned gen = old / nloc;
        if (old + 1u == (gen + 1u) * nloc) {
            __builtin_amdgcn_fence(__ATOMIC_RELEASE, "agent");
            asm volatile("s_waitcnt vmcnt(0)" ::: "memory");
            const unsigned og = xb_add(&bar[XB_TOP], 1u);
            const unsigned tg = og / nx;
            if (og + 1u == (tg + 1u) * nx) xb_add(&bar[XB_TOPGEN], 1u);
            else XB_SPIN(xb_ld(&bar[XB_TOPGEN]) == tg, bar);
            __builtin_amdgcn_fence(__ATOMIC_ACQUIRE, "agent");
            xb_add(&bar[XB_XGEN(b.x)], 1u);
            asm volatile("s_waitcnt vmcnt(0)" ::: "memory");
        } else {
            XB_SPIN(xb_ld(&bar[XB_XGEN(b.x)]) == gen, bar);
            __builtin_amdgcn_fence(__ATOMIC_ACQUIRE, "agent");
            asm volatile("s_waitcnt vmcnt(0)" ::: "memory");
        }
    }
    __syncthreads();
}

using namespace pg8;
#define LAS PG8_LAS
typedef unsigned u32x2 __attribute__((ext_vector_type(2)));

constexpr int T = 32768, D = 1024, SEQ = 16384, DFF = 2816, NMOD = 9216;
constexpr float EPS = 1e-6f;
constexpr int LDS_BYTES = 147456;

constexpr size_t OFF_MOD = 0;
constexpr size_t OFF_C2 = OFF_MOD + 294912;
constexpr size_t OFF_SSQ = OFF_C2 + 8192;
constexpr size_t OFF_VSTAT = OFF_SSQ + 2097152;
constexpr size_t OFF_CHA = OFF_VSTAT + 8388608;
constexpr size_t OFF_CHH = OFF_CHA + 1048576;
constexpr size_t OFF_WFI = OFF_CHH + 1048576;
constexpr size_t OFF_WFO = OFF_WFI + 92274688;
constexpr size_t OFF_WRI = OFF_WFO + 46137344;
constexpr size_t OFF_WRG = OFF_WRI + 8388608;
constexpr size_t OFF_WRO = OFF_WRG + 1048576;
constexpr size_t OFF_WGI = OFF_WRO + 4194304;
constexpr size_t OFF_WGS = OFF_WGI + 16777216;
constexpr size_t OFF_WGO = OFF_WGS + 524288;
constexpr size_t OFF_H = OFF_WGO + 8388608;
constexpr size_t OFF_O = OFF_H + 67108864;
constexpr size_t OFF_ACT = OFF_O + 67108864;
constexpr size_t OFF_BAR = OFF_ACT + 268435456;
constexpr size_t OFF_LOC = OFF_BAR + 16384;
constexpr size_t OFF_NSP = OFF_LOC + 4096;
constexpr size_t OFF_O2 = OFF_NSP + 8192;
constexpr size_t OFF_SSQ2 = OFF_O2 + 67108864;
constexpr size_t WS_END = OFF_SSQ2 + 2097152;
constexpr size_t REGB = 33554432;

struct Args {
    const float *x, *c, *ada_w, *ada_b, *norm_pre, *norm_post, *ffn_w_in, *ffn_w_out, *rg_w_in, *rg_conv_w, *rg_conv_b, *rg_w_a, *rg_b_a, *rg_w_x, *rg_b_x, *rg_lambda,
        *rg_w_out, *gm_w_in, *gm_ln_g, *gm_ln_b, *gm_w_s, *gm_b_s, *gm_w_out;
    float* out; unsigned char* ws;
};

__device__ __forceinline__ float bf_lo(unsigned w) { return __uint_as_float(w << 16); }
__device__ __forceinline__ float bf_hi(unsigned w) { return __uint_as_float(w & 0xffff0000u); }
__device__ __forceinline__ bf16_t f2bf(float f) { unsigned u = __float_as_uint(f); u += 0x7FFFu + ((u >> 16) & 1u); return (bf16_t)(u >> 16); }
__device__ __forceinline__ float sigm(float x) { return __builtin_amdgcn_rcpf(1.0f + __expf(-x)); }
__device__ __forceinline__ float silu_f(float x) { return x * sigm(x); }
__device__ __forceinline__ float gelu_t(float x) { const float t = x * fmaf(-0.10294324f, x * x, -2.3022082f); return x * __builtin_amdgcn_rcpf(1.0f + __builtin_amdgcn_exp2f(t)); }
__device__ __forceinline__ u32x4 pack8(const f32x4 a, const f32x4 b) { u32x4 w; w.x = cvt_pk_bf16(a[0], a[1]); w.y = cvt_pk_bf16(a[2], a[3]); w.z = cvt_pk_bf16(b[0], b[1]); w.w = cvt_pk_bf16(b[2], b[3]); return w; }
__device__ __forceinline__ void unpack8(const u32x4 w, float (&f)[8]) { f[0] = bf_lo(w.x); f[1] = bf_hi(w.x); f[2] = bf_lo(w.y); f[3] = bf_hi(w.y); f[4] = bf_lo(w.z); f[5] = bf_hi(w.z); f[6] = bf_lo(w.w); f[7] = bf_hi(w.w); }

__device__ __forceinline__ size_t act_off(int row, int pitchB, size_t sub) { return (size_t)(row >> 12) * REGB + sub + (size_t)(row & 4095) * (size_t)pitchB; }
__device__ __forceinline__ void xcc_local_barrier(unsigned* cnt, unsigned nloc) {
    asm volatile("s_waitcnt vmcnt(0)" ::: "memory");
    __syncthreads();
    if (threadIdx.x == 0) {
        __builtin_amdgcn_s_waitcnt(0);
        const unsigned old = xb_add(cnt, 1u); const unsigned target = (old / nloc + 1u) * nloc; unsigned sp = 0u;
        while (xb_ld(cnt) < target) { __builtin_amdgcn_s_sleep(1); if (++sp > (1u << 20)) break; }
        __builtin_amdgcn_fence(__ATOMIC_ACQUIRE, "agent");
        asm volatile("s_waitcnt vmcnt(0)" ::: "memory");
    }
    __syncthreads();
}

struct EpiSwiglu {
    static constexpr bool PERM = true, AFTER_DRAIN = false;
    bf16_t* O;
    __device__ __forceinline__ void operator()(const f32x4 (&acc)[2][2][4][2], const Unit& u, int wr, int wc, int fr, int fq) const {
        const int row0 = u.pm * BM + wr * 64 + fr, col0 = u.pn * 128 + wc * 32 + 8 * fq;
#pragma unroll
        for (int ai = 0; ai < 2; ++ai)
#pragma unroll
            for (int m = 0; m < 4; ++m) {
                f32x4 v0, v1;
#pragma unroll
                for (int j = 0; j < 4; ++j) { v0[j] = silu_f(acc[ai][0][m][0][j]) * acc[ai][1][m][0][j]; v1[j] = silu_f(acc[ai][0][m][1][j]) * acc[ai][1][m][1][j]; }
                *(u32x4*)((unsigned char*)O + act_off(row0 + ai * HALF + m * 16, DFF * 2, 0) + (size_t)col0 * 2) = pack8(v0, v1);
            }
    }
};
struct EpiOutSsq {
    static constexpr bool PERM = true, AFTER_DRAIN = false;
    bf16_t* O; float* ssq;
    __device__ __forceinline__ void operator()(const f32x4 (&acc)[2][2][4][2], const Unit& u, int wr, int wc, int fr, int fq) const {
        const int row0 = u.pm * BM + wr * 64 + fr, col0 = u.pn * BM + wc * 32 + 8 * fq;
#pragma unroll
        for (int ai = 0; ai < 2; ++ai)
#pragma unroll
            for (int m = 0; m < 4; ++m) {
                const int row = row0 + ai * HALF + m * 16; float s = 0.f;
#pragma unroll
                for (int bj = 0; bj < 2; ++bj) { const f32x4 v0 = acc[ai][bj][m][0], v1 = acc[ai][bj][m][1];
                    s += (v0[0] * v0[0] + v0[1] * v0[1]) + (v0[2] * v0[2] + v0[3] * v0[3]) + (v1[0] * v1[0] + v1[1] * v1[1]) + (v1[2] * v1[2] + v1[3] * v1[3]);
                    *(u32x4*)(O + (size_t)row * D + col0 + bj * HALF) = pack8(v0, v1); }
                s += __shfl_xor(s, 16); s += __shfl_xor(s, 32);
                if (fq == 0) ssq[(size_t)row * 16 + u.pn * 4 + wc] = s;
            }
    }
};
template <int GELU> struct EpiSplit {
    static constexpr bool PERM = true, AFTER_DRAIN = false;
    bf16_t* O0; bf16_t* O1; int half; float* vstat;
    __device__ __forceinline__ void operator()(const f32x4 (&acc)[2][2][4][2], const Unit& u, int wr, int wc, int fr, int fq) const {
        int colt = u.pn * BM; const bool second = colt >= half; if (second) colt -= half; const size_t sub = second ? (size_t)4096 * half * 2 : 0;
        const int row0 = u.pm * BM + wr * 64 + fr, col0 = colt + wc * 32 + 8 * fq; const int vt = colt >> 8;
#pragma unroll
        for (int ai = 0; ai < 2; ++ai)
#pragma unroll
            for (int m = 0; m < 4; ++m) {
                const int row = row0 + ai * HALF + m * 16; float s = 0.f, q = 0.f;
#pragma unroll
                for (int bj = 0; bj < 2; ++bj) { f32x4 v0 = acc[ai][bj][m][0], v1 = acc[ai][bj][m][1];
                    if (GELU) {
#pragma unroll
                        for (int j = 0; j < 4; ++j) { v0[j] = gelu_t(v0[j]); v1[j] = gelu_t(v1[j]); }
                        if (second) {
                        s += (v0[0] + v0[1]) + (v0[2] + v0[3]) + (v1[0] + v1[1]) + (v1[2] + v1[3]);
                        q += (v0[0] * v0[0] + v0[1] * v0[1]) + (v0[2] * v0[2] + v0[3] * v0[3]) + (v1[0] * v1[0] + v1[1] * v1[1]) + (v1[2] * v1[2] + v1[3] * v1[3]); } }
                    *(u32x4*)((unsigned char*)O0 + act_off(row, half * 2, sub) + (size_t)(col0 + bj * HALF) * 2) = pack8(v0, v1); }
                if (GELU && second) { s += __shfl_xor(s, 16); s += __shfl_xor(s, 32); q += __shfl_xor(q, 16); q += __shfl_xor(q, 32);
                    if (fq == 0) { float* p = vstat + ((size_t)row * 32 + vt * 4 + wc) * 2; p[0] = s; p[1] = q; } }
            }
    }
};

__device__ __forceinline__ void prep_phase(const Args& a, LAS unsigned char* lds) {
    int tid_ = threadIdx.x; asm volatile("" : "+v"(tid_)); const int tid = tid_, wid = tid >> 6, lane = tid & 63;
    float* MOD = (float*)(a.ws + OFF_MOD);
    {
        LAS float* sc = (LAS float*)lds;
        LAS float* red = sc + 2048;
        for (int i = tid; i < 2048; i += 512) sc[i] = silu_f(a.c[i]);
        __syncthreads();
        for (int it = blockIdx.x; it < 576; it += gridDim.x) {
            const int l = it / 144, nb = it % 144;
            const float* w = a.ada_w + ((size_t)l * 1024 + wid * 128) * NMOD + nb * 64 + lane;
            float a0 = 0.f, a1 = 0.f;
#pragma unroll 16
            for (int k = 0; k < 128; ++k) { const float wv = w[(size_t)k * NMOD]; a0 += sc[wid * 128 + k] * wv; a1 += sc[1024 + wid * 128 + k] * wv; }
            red[(wid * 64 + lane) * 2] = a0; red[(wid * 64 + lane) * 2 + 1] = a1;
            __syncthreads();
            if (tid < 128) { const int ln = tid & 63, b = tid >> 6; float s = 0.f;
#pragma unroll
                for (int w2 = 0; w2 < 8; ++w2) s += red[(w2 * 64 + ln) * 2 + b];
                MOD[(size_t)(l * 2 + b) * NMOD + nb * 64 + ln] = s + a.ada_b[(size_t)l * NMOD + nb * 64 + ln]; }
            __syncthreads();
        }
    }
    {
        LAS float* L = (LAS float*)lds;
        const bool bal = (gridDim.x == 256);
        const int tbeg = bal ? ((int)blockIdx.x < 64 ? (int)blockIdx.x * 18 : 1152 + ((int)blockIdx.x - 64) * 22) : (int)blockIdx.x;
        const int tend = bal ? tbeg + ((int)blockIdx.x < 64 ? 18 : 22) : 5376, tinc = bal ? 1 : (int)gridDim.x;
#define PREP_DECODE(tix_) \
            int t = (tix_), K, N, mode = 0; const float* src; bf16_t* dst; \
            if (t < 2816) { const int mi = t / 352; t %= 352; src = a.ffn_w_in + (size_t)mi * 1024 * 5632; dst = (bf16_t*)(a.ws + OFF_WFI) + (size_t)mi * 5632 * 1024; K = 1024; N = 5632; mode = 1; } \
            else if ((t -= 2816) < 1408) { const int mi = t / 176; t %= 176; src = a.ffn_w_out + (size_t)mi * 2816 * 1024; dst = (bf16_t*)(a.ws + OFF_WFO) + (size_t)mi * 1024 * 2816; K = 2816; N = 1024; } \
            else if ((t -= 1408) < 256) { const int mi = t / 128; t %= 128; src = a.rg_w_in + (size_t)mi * 1024 * 2048; dst = (bf16_t*)(a.ws + OFF_WRI) + (size_t)mi * 2048 * 1024; K = 1024; N = 2048; } \
            else if ((t -= 256) < 128) { const int mi = t / 64; t %= 64; src = a.rg_w_out + (size_t)mi * 1024 * 1024; dst = (bf16_t*)(a.ws + OFF_WRO) + (size_t)mi * 1024 * 1024; K = 1024; N = 1024; } \
            else if ((t -= 128) < 512) { const int mi = t / 256; t %= 256; src = a.gm_w_in + (size_t)mi * 1024 * 4096; dst = (bf16_t*)(a.ws + OFF_WGI) + (size_t)mi * 4096 * 1024; K = 1024; N = 4096; } \
            else { t -= 512; const int mi = t / 128; t %= 128; src = a.gm_w_out + (size_t)mi * 2048 * 1024; dst = (bf16_t*)(a.ws + OFF_WGO) + (size_t)mi * 1024 * 2048; K = 2048; N = 1024; } \
            const int ntn = N >> 8, kt = t / ntn, nt = t % ntn, k0 = kt * 64, n0 = nt * 256;
#define PREP_LOAD() _Pragma("unroll") for (int i = 0; i < 8; ++i) { const int idx = tid + 512 * i, row = idx >> 6, c4 = idx & 63; v[i] = *(const f32x4*)(src + (size_t)(k0 + row) * N + n0 + c4 * 4); }
        f32x4 v[8];
        if (tbeg < tend) { PREP_DECODE(tbeg) PREP_LOAD() (void)dst; (void)K; (void)mode; }
        for (int tix = tbeg; tix < tend; tix += tinc) {
#pragma unroll
            for (int i = 0; i < 8; ++i) { const int idx = tid + 512 * i, row = idx >> 6, c4 = idx & 63; *(LAS f32x4*)(L + row * 260 + c4 * 4) = v[i]; }
            if (tix + tinc < tend) { PREP_DECODE(tix + tinc) PREP_LOAD() (void)dst; (void)K; (void)mode; }
            __syncthreads();
            PREP_DECODE(tix)
            (void)src; (void)ntn; (void)kt; (void)nt;
            const int n = tid & 255, kh = tid >> 8, c = n0 + n; int drow = c;
            if (mode == 1) { const int up = c >= 2816, cc = up ? c - 2816 : c; drow = (cc >> 7) * 256 + up * 128 + (cc & 127); }
            bf16_t* dp = dst + (size_t)drow * K + k0 + kh * 32;
#pragma unroll
            for (int p = 0; p < 4; ++p) { f32x4 f0, f1;
#pragma unroll
                for (int j = 0; j < 4; ++j) { f0[j] = L[(kh * 32 + p * 8 + j) * 260 + n]; f1[j] = L[(kh * 32 + p * 8 + 4 + j) * 260 + n]; }
                *(u32x4*)(dp + p * 8) = pack8(f0, f1); }
            __syncthreads();
        }
#undef PREP_DECODE
#undef PREP_LOAD
    }
    {
        bf16_t* WRG = (bf16_t*)(a.ws + OFF_WRG);
        for (int idx = blockIdx.x * 512 + tid; idx < 524288; idx += gridDim.x * 512) {
            const int d = idx & 127, e = (idx >> 7) & 127, which = (idx >> 14) & 1, h = (idx >> 15) & 7, k2 = idx >> 18;
            const float* s = (which ? a.rg_w_x : a.rg_w_a) + (((size_t)(k2 * 8 + h) * 128 + d) * 128 + e);
            WRG[idx] = f2bf(*s);
        }
    }
    {
        float* NSP = (float*)(a.ws + OFF_NSP);
        for (int i = blockIdx.x * 512 + tid; i < 2048; i += gridDim.x * 512) NSP[i] = -8.0f * log1pf(expf(-a.rg_lambda[i])) * 1.4426950408889634f;
    }
    {
        bf16_t* WGS = (bf16_t*)(a.ws + OFF_WGS); float* C2 = (float*)(a.ws + OFF_C2);
        for (int row = blockIdx.x * 8 + wid; row < 2048; row += gridDim.x * 8) {
            const int t = row & 127; float sum = 0.f;
#pragma unroll
            for (int s = lane; s < 128; s += 64) { float w = a.gm_w_s[(size_t)row * 128 + s]; if (s > t) w = 0.f; WGS[(size_t)row * 128 + s] = f2bf(w); sum += w; }
#pragma unroll
            for (int o = 32; o >= 1; o >>= 1) sum += __shfl_xor(sum, o);
            if (lane == 0) C2[row] = sum;
        }
    }
}

__device__ __forceinline__ void ew_phase(const Args& a, int vb, int sp, int sn, int wm, const float* xin, float* xout, bf16_t* H) {
    int tid_ = threadIdx.x; asm volatile("" : "+v"(tid_)); const int tid = tid_, wid = tid >> 6, lane = tid & 63;
    const float* MOD = (const float*)(a.ws + OFF_MOD);
    const float* SSQc = (const float*)(a.ws + ((sp & 1) ? OFF_SSQ2 : OFF_SSQ)); const bf16_t* Oc = (const bf16_t*)(a.ws + ((sp & 1) ? OFF_O2 : OFF_O));
    const float* SSQp = (const float*)(a.ws + OFF_SSQ); const bf16_t* Op = (const bf16_t*)(a.ws + OFF_O);
    for (int rb = vb * 8 + wid; rb < T / 16; rb += gridDim.x * 8) {
        const int row0 = rb * 16, b = row0 >> 14;
        f32x4 pg[4], pgp[4], ps[4], pb[4];
#pragma unroll
        for (int k = 0; k < 4; ++k) { pg[k] = (f32x4){0.f, 0.f, 0.f, 0.f}; pgp[k] = pg[k]; ps[k] = pg[k]; pb[k] = pg[k]; }
        if (sp >= 0) { const int l = sp / 3, j = sp % 3; const float resw = (j == 1) ? 1.0f : 0.5f;
            const float* gate = MOD + (size_t)(l * 2 + b) * NMOD + j * 3072 + 2048 + 4 * lane; const float* gp = a.norm_post + (size_t)(l * 3 + j) * D + 4 * lane;
#pragma unroll
            for (int k = 0; k < 4; ++k) pg[k] = resw * (*(const f32x4*)(gate + 256 * k)) * (*(const f32x4*)(gp + 256 * k)); }
        if (wm == 2) { const int s2 = sp - 1, l = s2 / 3, j = s2 % 3; const float resw = (j == 1) ? 1.0f : 0.5f;
            const float* gate = MOD + (size_t)(l * 2 + b) * NMOD + j * 3072 + 2048 + 4 * lane; const float* gp = a.norm_post + (size_t)(l * 3 + j) * D + 4 * lane;
#pragma unroll
            for (int k = 0; k < 4; ++k) pgp[k] = resw * (*(const f32x4*)(gate + 256 * k)) * (*(const f32x4*)(gp + 256 * k)); }
        if (sn >= 0) { const int l = sn / 3, j = sn % 3;
            const float* shift = MOD + (size_t)(l * 2 + b) * NMOD + j * 3072 + 4 * lane; const float* gpre = a.norm_pre + (size_t)(l * 3 + j) * D + 4 * lane;
#pragma unroll
            for (int k = 0; k < 4; ++k) { ps[k] = (*(const f32x4*)(gpre + 256 * k)) * (1.0f + *(const f32x4*)(shift + 1024 + 256 * k)); pb[k] = *(const f32x4*)(shift + 256 * k); } }
        f32x4 xn[4]; u32x2 on[4], opn[4]; float sn_ = 0.f, spn_ = 0.f;
#pragma unroll
        for (int k = 0; k < 4; ++k) { on[k] = (u32x2){0u, 0u}; opn[k] = on[k]; }
#define EW_LOADROW(rowi) do { const size_t ro_ = (size_t)(rowi) * D + 4 * lane; \
            _Pragma("unroll") for (int k = 0; k < 4; ++k) xn[k] = __builtin_nontemporal_load((const f32x4*)(xin + ro_ + 256 * k)); \
            if (sp >= 0) { sn_ = SSQc[(size_t)(rowi) * 16 + (lane & 15)]; \
                _Pragma("unroll") for (int k = 0; k < 4; ++k) on[k] = *(const u32x2*)(Oc + ro_ + 256 * k); } \
            if (wm == 2) { spn_ = SSQp[(size_t)(rowi) * 16 + (lane & 15)]; \
                _Pragma("unroll") for (int k = 0; k < 4; ++k) opn[k] = *(const u32x2*)(Op + ro_ + 256 * k); } } while (0)
        EW_LOADROW(row0);
        for (int rr = 0; rr < 16; ++rr) {
            const size_t ro = (size_t)(row0 + rr) * D + 4 * lane;
            f32x4 x[4]; u32x2 oc[4], opc[4]; float s = sn_, s2 = spn_;
#pragma unroll
            for (int k = 0; k < 4; ++k) { x[k] = xn[k]; oc[k] = on[k]; opc[k] = opn[k]; }
            if (rr < 15) EW_LOADROW(row0 + rr + 1);
            if (wm == 2) {
                s2 += __shfl_xor(s2, 1); s2 += __shfl_xor(s2, 2); s2 += __shfl_xor(s2, 4); s2 += __shfl_xor(s2, 8);
                const float rstd2 = rsqrtf(s2 * (1.0f / 1024.0f) + EPS);
#pragma unroll
                for (int k = 0; k < 4; ++k) { const u32x2 ow = opc[k]; const f32x4 o = (f32x4){bf_lo(ow.x), bf_hi(ow.x), bf_lo(ow.y), bf_hi(ow.y)}; x[k] += pgp[k] * (o * rstd2); }
            }
            if (sp >= 0) {
                s += __shfl_xor(s, 1); s += __shfl_xor(s, 2); s += __shfl_xor(s, 4); s += __shfl_xor(s, 8);
                const float rstd = rsqrtf(s * (1.0f / 1024.0f) + EPS);
#pragma unroll
                for (int k = 0; k < 4; ++k) { const u32x2 ow = oc[k]; const f32x4 o = (f32x4){bf_lo(ow.x), bf_hi(ow.x), bf_lo(ow.y), bf_hi(ow.y)};
                    x[k] += pg[k] * (o * rstd); if (wm == 2) __builtin_nontemporal_store(x[k], (f32x4*)(xout + ro + 256 * k)); }
            }
            if (sn >= 0) {
                float ss = 0.f;
#pragma unroll
                for (int k = 0; k < 4; ++k) ss += (x[k][0] * x[k][0] + x[k][1] * x[k][1]) + (x[k][2] * x[k][2] + x[k][3] * x[k][3]);
#pragma unroll
                for (int o = 32; o >= 1; o >>= 1) ss += __shfl_xor(ss, o);
                const float rs = rsqrtf(ss * (1.0f / 1024.0f) + EPS);
#pragma unroll
                for (int k = 0; k < 4; ++k) { const f32x4 hv = (x[k] * rs) * ps[k] + pb[k]; u32x2 w; w.x = cvt_pk_bf16(hv[0], hv[1]); w.y = cvt_pk_bf16(hv[2], hv[3]); *(u32x2*)(H + ro + 256 * k) = w; }
            }
        }
#undef EW_LOADROW
    }
}

__device__ __forceinline__ void rg_scan_phase(const Args& a, int vb, int k2, LAS unsigned char* lds) {
    int tid_ = threadIdx.x; asm volatile("" : "+v"(tid_)); const int tid = tid_, wid = tid >> 6, lane = tid & 63, fr = lane & 15, fq = lane >> 4;
    LAS float* XC = (LAS float*)lds; LAS float* SA = XC + 128 * 132; LAS float* SEG = SA + 128 * 132;
    unsigned char* AB = a.ws + OFF_ACT;
    float* CHA = (float*)(a.ws + OFF_CHA); float* CHH = (float*)(a.ws + OFF_CHH);
    const float* cw = a.rg_conv_w + (size_t)k2 * 4 * D; const float* cb = a.rg_conv_b + (size_t)k2 * D;
    for (int ch = vb; ch < 256; ch += gridDim.x) {
      const int t0 = ch * 128; const bool first = (t0 & (SEQ - 1)) == 0;
      u32x4 xq[7];
#define RG_PF_CONV(hh) do { const int c0_ = (hh) * 128 + (tid & 15) * 8; \
        _Pragma("unroll") for (int r = 0; r < 7; ++r) { const int tt = 4 * (tid >> 4) - 3 + r; \
            if (tt < 0 && first) xq[r] = (u32x4){0u, 0u, 0u, 0u}; else xq[r] = *(const u32x4*)(AB + act_off(t0 + tt, 2048, 0) + (size_t)c0_ * 2); } } while (0)
      RG_PF_CONV(0);
#pragma unroll 1
      for (int h = 0; h < 8; ++h) {
        {
            const int cg8 = tid & 15, tq = tid >> 4, c0 = h * 128 + cg8 * 8;
            float w[4][8], bias[8], xr[7][8];
#pragma unroll
            for (int k = 0; k < 4; ++k) { const f32x4 w0 = *(const f32x4*)(cw + k * D + c0), w1 = *(const f32x4*)(cw + k * D + c0 + 4);
#pragma unroll
                for (int j = 0; j < 4; ++j) { w[k][j] = w0[j]; w[k][4 + j] = w1[j]; } }
            { const f32x4 b0 = *(const f32x4*)(cb + c0), b1 = *(const f32x4*)(cb + c0 + 4);
#pragma unroll
                for (int j = 0; j < 4; ++j) { bias[j] = b0[j]; bias[4 + j] = b1[j]; } }
#pragma unroll
            for (int r = 0; r < 7; ++r) unpack8(xq[r], xr[r]);
#pragma unroll
            for (int q = 0; q < 4; ++q) { f32x4 o0, o1;
#pragma unroll
                for (int j = 0; j < 4; ++j) {
                    o0[j] = bias[j] + w[0][j] * xr[q][j] + w[1][j] * xr[q + 1][j] + w[2][j] * xr[q + 2][j] + w[3][j] * xr[q + 3][j];
                    o1[j] = bias[4 + j] + w[0][4 + j] * xr[q][4 + j] + w[1][4 + j] * xr[q + 1][4 + j] + w[2][4 + j] * xr[q + 2][4 + j] + w[3][4 + j] * xr[q + 3][4 + j]; }
                *(LAS f32x4*)(XC + (4 * tq + q) * 132 + cg8 * 8) = o0; *(LAS f32x4*)(XC + (4 * tq + q) * 132 + cg8 * 8 + 4) = o1; }
        }
        __syncthreads();
        f32x4 bval[8];
        const int cl = 16 * wid + 4 * fq;
        {
            const bf16_t* Wg = (const bf16_t*)(a.ws + OFF_WRG) + (size_t)(k2 * 8 + h) * 256 * 128;
            bf16x8 bfr[2][4];
#pragma unroll
            for (int wh = 0; wh < 2; ++wh)
#pragma unroll
                for (int ks = 0; ks < 4; ++ks) bfr[wh][ks] = *(const bf16x8*)(Wg + (size_t)(wh * 128 + 16 * wid + fr) * 128 + 32 * ks + 8 * fq);
            const int c = k2 * D + h * 128 + cl;
            const f32x4 ba = *(const f32x4*)(a.rg_b_a + c) * -1.4426950408889634f, bx = *(const f32x4*)(a.rg_b_x + c) * -1.4426950408889634f, nsp = *(const f32x4*)((const float*)(a.ws + OFF_NSP) + c);
#pragma unroll
            for (int mb = 0; mb < 8; ++mb) {
                f32x4 accR = (f32x4){0.f, 0.f, 0.f, 0.f}, accI = accR;
                {
                    const LAS float* p = XC + (16 * mb + fr) * 132 + 8 * fq; f32x4 v[8];
                    asm volatile("ds_read_b128 %0, %8\n\tds_read_b128 %1, %8 offset:16\n\tds_read_b128 %2, %8 offset:128\n\tds_read_b128 %3, %8 offset:144\n\t"
                                 "ds_read_b128 %4, %8 offset:256\n\tds_read_b128 %5, %8 offset:272\n\tds_read_b128 %6, %8 offset:384\n\tds_read_b128 %7, %8 offset:400\n\ts_waitcnt lgkmcnt(0)"
                                 : "=&v"(v[0]), "=&v"(v[1]), "=&v"(v[2]), "=&v"(v[3]), "=&v"(v[4]), "=&v"(v[5]), "=&v"(v[6]), "=&v"(v[7]) : "v"(p) : "memory");
#pragma unroll
                    for (int ks = 0; ks < 4; ++ks) { const u32x4 pk = pack8(v[2 * ks], v[2 * ks + 1]); const bf16x8 af = __builtin_bit_cast(bf16x8, pk);
                        accR = __builtin_amdgcn_mfma_f32_16x16x32_bf16(bfr[0][ks], af, accR, 0, 0, 0); accI = __builtin_amdgcn_mfma_f32_16x16x32_bf16(bfr[1][ks], af, accI, 0, 0, 0); } }
                const int t = 16 * mb + fr; const f32x4 xc = *(const LAS f32x4*)(XC + t * 132 + cl); f32x4 av;
#pragma unroll
                for (int j = 0; j < 4; ++j) {
                    const float r = __builtin_amdgcn_rcpf(1.0f + __builtin_amdgcn_exp2f(fmaf(accR[j], -1.4426950408889634f, ba[j])));
                    const float ig = __builtin_amdgcn_rcpf(1.0f + __builtin_amdgcn_exp2f(fmaf(accI[j], -1.4426950408889634f, bx[j])));
                    const float aa = __builtin_amdgcn_exp2f(nsp[j] * r); av[j] = aa; bval[mb][j] = __builtin_amdgcn_sqrtf(fmaxf(1.0f - aa * aa, 0.f)) * (ig * xc[j]); }
                *(LAS f32x4*)(SA + t * 132 + cl) = av;
            }
        }
        __syncthreads();
#pragma unroll
        for (int mb = 0; mb < 8; ++mb) *(LAS f32x4*)(XC + (16 * mb + fr) * 132 + cl) = bval[mb];
        __syncthreads();
        if (h < 7) RG_PF_CONV(h + 1);
        {
            const int c = tid & 127, sg = tid >> 7;
            float P = 1.f, Hh = 0.f;
#pragma unroll 1
            for (int ib = 0; ib < 4; ++ib) {
                float av[8], bv[8];
#pragma unroll
                for (int i = 0; i < 8; ++i) { const int t = 32 * sg + 8 * ib + i; av[i] = SA[t * 132 + c]; bv[i] = XC[t * 132 + c]; }
#pragma unroll
                for (int i = 0; i < 8; ++i) { Hh = av[i] * Hh + bv[i]; P *= av[i]; bv[i] = Hh; av[i] = P; }
#pragma unroll
                for (int i = 0; i < 8; ++i) { const int t = 32 * sg + 8 * ib + i; XC[t * 132 + c] = bv[i]; SA[t * 132 + c] = av[i]; }
            }
            SEG[(sg * 128 + c) * 2] = P; SEG[(sg * 128 + c) * 2 + 1] = Hh;
        }
        __syncthreads();
        {
            const int cg8 = tid & 15, tq = tid >> 4;
            float Ain[8], Hin[8];
#pragma unroll
            for (int j = 0; j < 8; ++j) { Ain[j] = 1.f; Hin[j] = 0.f; }
#pragma unroll
            for (int i = 0; i < 4; ++i) { const int t = tq + 32 * i; const size_t cb2 = (size_t)(h * 128 + cg8 * 8) * 2;
                const LAS float* p = XC + t * 132 + cg8 * 8; const LAS float* q = SA + t * 132 + cg8 * 8;
                const f32x4 h0 = *(const LAS f32x4*)p, h1 = *(const LAS f32x4*)(p + 4), p0 = *(const LAS f32x4*)q, p1 = *(const LAS f32x4*)(q + 4);
                f32x4 ho0, ho1, po0, po1;
#pragma unroll
                for (int j = 0; j < 4; ++j) { ho0[j] = h0[j] + p0[j] * Hin[j]; po0[j] = p0[j] * Ain[j]; ho1[j] = h1[j] + p1[j] * Hin[4 + j]; po1[j] = p1[j] * Ain[4 + j]; }
                *(u32x4*)(AB + act_off(t0 + t, 2048, (size_t)16 << 20) + cb2) = pack8(ho0, ho1);
                *(u32x4*)(AB + act_off(t0 + t, 2048, (size_t)24 << 20) + cb2) = pack8(po0, po1);
#pragma unroll
                for (int j2 = 0; j2 < 4; ++j2) { const f32x4 sv = *(const LAS f32x4*)(SEG + (i * 128 + cg8 * 8 + 2 * j2) * 2);
                    Hin[2 * j2] = sv[0] * Hin[2 * j2] + sv[1]; Ain[2 * j2] *= sv[0]; Hin[2 * j2 + 1] = sv[2] * Hin[2 * j2 + 1] + sv[3]; Ain[2 * j2 + 1] *= sv[2]; } }
            if (tq == 0) {
#pragma unroll
                for (int j = 0; j < 8; ++j) { CHA[(size_t)ch * D + h * 128 + cg8 * 8 + j] = Ain[j]; CHH[(size_t)ch * D + h * 128 + cg8 * 8 + j] = Hin[j]; } }
        }
        __syncthreads();
      }
#undef RG_PF_CONV
    }
}

__device__ __forceinline__ void rg_out_phase(const Args& a, int vb, LAS unsigned char* lds) {
    int tid_ = threadIdx.x; asm volatile("" : "+v"(tid_)); const int tid = tid_;
    LAS float* CAR = (LAS float*)lds;
    unsigned char* AB = a.ws + OFF_ACT;
    const float* CHA = (const float*)(a.ws + OFF_CHA); const float* CHH = (const float*)(a.ws + OFF_CHH);
    for (int ch = vb; ch < 256; ch += gridDim.x) {
        const int firstc = ch & ~127, t0 = ch * 128;
        {
            const int q = tid & 255, hv = tid >> 8, n = ch - firstc, nlo = n >> 1, jb = firstc + (hv ? nlo : 0), je = hv ? ch : firstc + nlo;
            f32x4 Aa = (f32x4){1.f, 1.f, 1.f, 1.f}, Hh = (f32x4){0.f, 0.f, 0.f, 0.f};
#pragma unroll 8
            for (int j = jb; j < je; ++j) { const f32x4 av = *(const f32x4*)(CHA + (size_t)j * D + 4 * q), hv4 = *(const f32x4*)(CHH + (size_t)j * D + 4 * q); Hh = av * Hh + hv4; Aa = Aa * av; }
            LAS f32x4* TMP = (LAS f32x4*)(CAR + 1024);
            if (hv) { TMP[q * 2] = Aa; TMP[q * 2 + 1] = Hh; }
            __syncthreads();
            if (!hv) { const f32x4 A2 = TMP[q * 2], H2 = TMP[q * 2 + 1]; *(LAS f32x4*)(CAR + 4 * q) = A2 * Hh + H2; }
        }
        __syncthreads();
        const int cg8 = tid & 127; const f32x4 ca = *(const LAS f32x4*)(CAR + cg8 * 8), cb = *(const LAS f32x4*)(CAR + cg8 * 8 + 4);
        const float car[8] = {ca[0], ca[1], ca[2], ca[3], cb[0], cb[1], cb[2], cb[3]};
        const size_t cb2 = (size_t)cg8 * 16;
#pragma unroll 1
        for (int ib = 0; ib < 8; ++ib) {
            u32x4 qh[4], qa[4], qg[4];
#pragma unroll
            for (int k = 0; k < 4; ++k) { const int t = (tid >> 7) + 4 * (4 * ib + k);
                qh[k] = *(const u32x4*)(AB + act_off(t0 + t, 2048, (size_t)16 << 20) + cb2); qa[k] = *(const u32x4*)(AB + act_off(t0 + t, 2048, (size_t)24 << 20) + cb2);
                qg[k] = *(const u32x4*)(AB + act_off(t0 + t, 2048, (size_t)8 << 20) + cb2); }
#pragma unroll
            for (int k = 0; k < 4; ++k) { const int t = (tid >> 7) + 4 * (4 * ib + k);
                float hl[8], ap[8], gb[8]; unpack8(qh[k], hl); unpack8(qa[k], ap); unpack8(qg[k], gb);
                f32x4 y0, y1;
#pragma unroll
                for (int j = 0; j < 4; ++j) { y0[j] = (hl[j] + ap[j] * car[j]) * gelu_t(gb[j]); y1[j] = (hl[4 + j] + ap[4 + j] * car[4 + j]) * gelu_t(gb[4 + j]); }
                *(u32x4*)(AB + act_off(t0 + t, 2048, (size_t)8 << 20) + cb2) = pack8(y0, y1); }
        }
        __syncthreads();
    }
}

__device__ __forceinline__ void gm_gate_phase(const Args& a, int vb, int k2, LAS unsigned char* lds) {
    int tid_ = threadIdx.x; asm volatile("" : "+v"(tid_)); const int tid = tid_, wid = tid >> 6, lane = tid & 63, fr = lane & 15, fq = lane >> 4;
    constexpr int VS = 272, AS = 136;
    LAS bf16_t* VT = (LAS bf16_t*)lds;
    LAS bf16_t* AW = VT + 128 * VS;
    LAS float* MU = (LAS float*)(AW + 128 * AS); LAS float* RSTD = MU + 128; LAS float* C1 = RSTD + 128; LAS float* C2S = C1 + 128; LAS float* BSS = C2S + 128;
    unsigned char* AB = a.ws + OFF_ACT;
    const float* VSTAT = (const float*)(a.ws + OFF_VSTAT); const float* C2 = (const float*)(a.ws + OFF_C2);
    const bf16_t* WGS = (const bf16_t*)(a.ws + OFF_WGS);
    for (int ch = vb; ch < 256; ch += gridDim.x) {
        const int t0 = ch * 128;
        u32x4 vq[8], wq4[4];
        { const bf16_t* wp0 = WGS + ((size_t)(k2 * 8 + 0) * 128 + (tid >> 2)) * 128 + 32 * (tid & 3);
#pragma unroll
          for (int p = 0; p < 4; ++p) wq4[p] = *(const u32x4*)(wp0 + 8 * p); }
#pragma unroll
        for (int i = 0; i < 8; ++i) { const int item = tid + 512 * i, row = item >> 5, c16 = item & 31; vq[i] = *(const u32x4*)(AB + act_off(t0 + row, 4096, (size_t)16 << 20) + (size_t)c16 * 16); }
        if (tid < 128) { const float* p = VSTAT + (size_t)(t0 + tid) * 64; float s = 0.f, q = 0.f;
#pragma unroll
            for (int i = 0; i < 16; ++i) { const f32x4 v = *(const f32x4*)(p + 4 * i); s += v[0] + v[2]; q += v[1] + v[3]; }
            const float mu = s * (1.0f / 2048.0f), var = fmaxf(q * (1.0f / 2048.0f) - mu * mu, 0.f); MU[tid] = mu; RSTD[tid] = rsqrtf(var + EPS); }
        __syncthreads();
        for (int g = 0; g < 8; ++g) {
            const int d0 = g * 256 + 32 * wid + 8 * fq;
            u32x4 uq[8];
#pragma unroll
            for (int mb = 0; mb < 8; ++mb)
                uq[mb] = *(const u32x4*)(AB + act_off(t0 + 16 * mb + fr, 4096, 0) + (size_t)d0 * 2);
            {
                const int t = tid >> 2, sq = tid & 3; float c1 = 0.f;
                if (tid < 128) { C2S[tid] = C2[(k2 * 8 + g) * 128 + tid]; BSS[tid] = a.gm_b_s[(size_t)(k2 * 8 + g) * 128 + tid]; }
#pragma unroll
                for (int p = 0; p < 4; ++p) { float f[8]; unpack8(wq4[p], f); f32x4 f0, f1;
#pragma unroll
                    for (int j = 0; j < 4; ++j) { f0[j] = f[j] * RSTD[32 * sq + 8 * p + j]; f1[j] = f[4 + j] * RSTD[32 * sq + 8 * p + 4 + j]; }
                    const u32x4 pk = pack8(f0, f1); float fr8[8]; unpack8(pk, fr8);
#pragma unroll
                    for (int j = 0; j < 8; ++j) c1 += fr8[j] * MU[32 * sq + 8 * p + j];
                    *(LAS u32x4*)(AW + t * AS + 32 * sq + 8 * p) = pk; }
                c1 += __shfl_xor(c1, 1); c1 += __shfl_xor(c1, 2);
                if (sq == 0) C1[t] = c1;
            }
            {
#pragma unroll
                for (int i = 0; i < 8; ++i) { const int item = tid + 512 * i, row = item >> 5, c16 = item & 31; const u32x4 q = vq[i];
                    LAS u32x2* dp = (LAS u32x2*)(VT + row * VS + 8 * c16); dp[0] = (u32x2){q.x, q.y}; dp[1] = (u32x2){q.z, q.w}; }
            }
            __syncthreads();
            if (g < 7) {
                { const bf16_t* wpn = WGS + ((size_t)(k2 * 8 + g + 1) * 128 + (tid >> 2)) * 128 + 32 * (tid & 3);
#pragma unroll
                  for (int p = 0; p < 4; ++p) wq4[p] = *(const u32x4*)(wpn + 8 * p); }
#pragma unroll
                for (int i = 0; i < 8; ++i) { const int item = tid + 512 * i, row = item >> 5, c16 = item & 31; vq[i] = *(const u32x4*)(AB + act_off(t0 + row, 4096, (size_t)16 << 20) + (size_t)((g + 1) * 256 + 8 * c16) * 2); } }
            f32x4 gd[2], bd[2];
#pragma unroll
            for (int nb = 0; nb < 2; ++nb) { gd[nb] = *(const f32x4*)(a.gm_ln_g + (size_t)k2 * 2048 + d0 + 4 * nb); bd[nb] = *(const f32x4*)(a.gm_ln_b + (size_t)k2 * 2048 + d0 + 4 * nb); }
#pragma unroll 1
            for (int hf = 0; hf < 2; ++hf) {
                float c2t[4], bst[4];
#pragma unroll
                for (int ml = 0; ml < 4; ++ml) { const int t = 64 * hf + 16 * ml + fr;
                    c2t[ml] = C2S[t]; bst[ml] = BSS[t];
                }
                f32x4 acc[4][2];
#pragma unroll
                for (int ml = 0; ml < 4; ++ml) { acc[ml][0] = (f32x4){0.f, 0.f, 0.f, 0.f}; acc[ml][1] = acc[ml][0]; }
#pragma unroll 1
                for (int ks = 0; ks < 2 * hf + 2; ++ks) {
                    bf16x8 vf[2];
                    {
                        const LAS bf16_t* vp = VT + (32 * ks + 8 * fq + ((lane & 15) >> 2)) * VS + 32 * wid + 8 * (lane & 3);
                        u32x2 r00, r01, r10, r11;
                        asm volatile("ds_read_b64_tr_b16 %0, %4\n\tds_read_b64_tr_b16 %1, %4 offset:2176\n\tds_read_b64_tr_b16 %2, %4 offset:8\n\tds_read_b64_tr_b16 %3, %4 offset:2184\n\ts_waitcnt lgkmcnt(0)"
                                     : "=&v"(r00), "=&v"(r01), "=&v"(r10), "=&v"(r11) : "v"(vp) : "memory");
                        vf[0] = __builtin_bit_cast(bf16x8, (u32x4){r00.x, r00.y, r01.x, r01.y});
                        vf[1] = __builtin_bit_cast(bf16x8, (u32x4){r10.x, r10.y, r11.x, r11.y}); }
                    bf16x8 af4[4];
                    {   const LAS bf16_t* ap = AW + (64 * hf + fr) * AS + 32 * ks + 8 * fq;
                        asm volatile("ds_read_b128 %0, %4\n\tds_read_b128 %1, %4 offset:4352\n\tds_read_b128 %2, %4 offset:8704\n\tds_read_b128 %3, %4 offset:13056\n\ts_waitcnt lgkmcnt(0)"
                                     : "=&v"(af4[0]), "=&v"(af4[1]), "=&v"(af4[2]), "=&v"(af4[3]) : "v"(ap) : "memory"); }
#pragma unroll
                    for (int ml = 0; ml < 4; ++ml) if (64 * hf + 16 * ml + 15 >= 32 * ks) {
                        acc[ml][0] = __builtin_amdgcn_mfma_f32_16x16x32_bf16(vf[0], af4[ml], acc[ml][0], 0, 0, 0);
                        acc[ml][1] = __builtin_amdgcn_mfma_f32_16x16x32_bf16(vf[1], af4[ml], acc[ml][1], 0, 0, 0); }
                }
#pragma unroll
                for (int ml = 0; ml < 4; ++ml) { const int t = 64 * hf + 16 * ml + fr; const float c1t = C1[t];
                    const u32x4 uw = hf ? uq[4 + ml] : uq[ml];
                    const f32x4 u0 = (f32x4){bf_lo(uw.x), bf_hi(uw.x), bf_lo(uw.y), bf_hi(uw.y)}, u1 = (f32x4){bf_lo(uw.z), bf_hi(uw.z), bf_lo(uw.w), bf_hi(uw.w)};
                    const f32x4 y0 = u0 * (gd[0] * (acc[ml][0] - c1t) + bd[0] * c2t[ml] + bst[ml]), y1 = u1 * (gd[1] * (acc[ml][1] - c1t) + bd[1] * c2t[ml] + bst[ml]);
                    *(u32x4*)(AB + act_off(t0 + t, 4096, 0) + (size_t)d0 * 2) = pack8(y0, y1); }
            }
            __syncthreads();
        }
    }
}

template <class Epi> __device__ __forceinline__ void run_gemm(LAS unsigned char* lds, int c, const bf16_t* A, size_t ars, const bf16_t* Bt, int N, int K, const Epi& E) {
    StaticOrder S; S.init(T, N, (int)gridDim.x, c);
    Gemm g; g.A = A; g.Bt = Bt; g.M = T; g.N = N; g.K = K; g.ars = ars;
    gemm_phase<Epi, StaticOrder, false>(lds, g, S, E, nullptr);
}

__global__ void __launch_bounds__(512) fwd_megakernel(Args a) {
    extern __shared__ __attribute__((aligned(16))) unsigned char shm[];
    LAS unsigned char* lds = (LAS unsigned char*)shm;
    cg::grid_group grid = cg::this_grid();
#ifdef TPROBE
    const unsigned long long tkstart = __builtin_amdgcn_s_memrealtime();
#endif
    volatile LAS unsigned* xst = (volatile LAS unsigned*)(lds + LDS_BYTES - 16);
    unsigned* LOC = (unsigned*)(a.ws + OFF_LOC);
    const unsigned myx = xb_xcc_id() & 7u;
    if (threadIdx.x == 0) { xst[0] = 0u; xst[1] = 0u; xst[2] = xb_add(LOC + 64 * myx, 1u); }
    __syncthreads();
    const XcdBarrier xb = xcd_barrier_post((unsigned*)(a.ws + OFF_BAR), xst);
    const unsigned myr = xst[2];
    bf16_t* H = (bf16_t*)(a.ws + OFF_H); bf16_t* O = (bf16_t*)(a.ws + OFF_O); bf16_t* ACT = (bf16_t*)(a.ws + OFF_ACT);
    float* SSQ = (float*)(a.ws + OFF_SSQ);

    prep_phase(a, lds);
    if (a.ws == nullptr) grid.sync();
    xcd_barrier(xb);
#ifdef FORCE_FALLBACK
    bool okl = false;
#else
    bool okl = (gridDim.x == 256);
#endif
#pragma unroll
    for (int x = 0; x < 8; ++x) okl = okl && (xb_ld(LOC + 64 * x) == 32u);
    const int vb = okl ? (int)(myx * 32u + myr) : (int)blockIdx.x;
    const int cg_ = okl ? (int)(myr * 8u + myx) : (int)blockIdx.x;
    unsigned* lcnt = LOC + 64 * (8 + myx);
#ifdef TPROBE
    unsigned long long tacc = 0ull, tprev = __builtin_amdgcn_s_memrealtime(); int tcur = 1; if (TPROBE == 3) tacc = tprev - tkstart;
#define TCAT(c) tcur = (c)
#define TSTAMP() do { const unsigned long long t_ = __builtin_amdgcn_s_memrealtime(); if (tcur == TPROBE) tacc += t_ - tprev; tprev = t_; } while (0)
#define GSYNC() do { xcd_barrier(xb); TSTAMP(); } while (0)
#else
#define TCAT(c)
#define TSTAMP()
#define GSYNC() xcd_barrier(xb)
#endif
#define LSYNC() do { if (okl) xcc_local_barrier(lcnt, 32u); else xcd_barrier(xb); TSTAMP(); } while (0)
    const size_t ARS_H = (size_t)4096 * D * 2;

    TCAT(1); ew_phase(a, vb, -1, 0, 0, a.x, a.out, H);
    LSYNC();
    for (int si = 0; si < 12; ++si) {
        const int l = si / 3, j = si % 3, k2 = l >> 1;
        const int type = (j != 1) ? 0 : ((l & 1) ? 2 : 1);
        const bf16_t* A2; const bf16_t* B2; int K2;
        if (type == 0) {
            const int fi = l * 2 + (j >> 1);
            EpiSwiglu e; e.O = ACT; TCAT(0);
            run_gemm(lds, cg_, H, ARS_H, (const bf16_t*)(a.ws + OFF_WFI) + (size_t)fi * 5632 * 1024, 5632, 1024, e);
            A2 = ACT; B2 = (const bf16_t*)(a.ws + OFF_WFO) + (size_t)fi * 1024 * 2816; K2 = 2816;
            LSYNC();
        } else if (type == 1) {
            TCAT(0); EpiSplit<0> e; e.O0 = ACT; e.O1 = nullptr; e.half = 1024; e.vstat = nullptr;
            run_gemm(lds, cg_, H, ARS_H, (const bf16_t*)(a.ws + OFF_WRI) + (size_t)k2 * 2048 * 1024, 2048, 1024, e);
            GSYNC();
            TCAT(2); rg_scan_phase(a, vb, k2, lds);
            GSYNC();
#ifdef SKEW_ITERS
            if (okl && myx >= 4u) { for (int i_ = 0; i_ < SKEW_ITERS; ++i_) __builtin_amdgcn_s_sleep(127); }
#endif
            TCAT(5); rg_out_phase(a, vb, lds);
            A2 = (const bf16_t*)((const unsigned char*)ACT + ((size_t)8 << 20)); B2 = (const bf16_t*)(a.ws + OFF_WRO) + (size_t)k2 * 1024 * 1024; K2 = 1024;
            LSYNC();
        } else {
            TCAT(0); EpiSplit<1> e; e.O0 = ACT; e.O1 = nullptr; e.half = 2048; e.vstat = (float*)(a.ws + OFF_VSTAT);
            run_gemm(lds, cg_, H, ARS_H, (const bf16_t*)(a.ws + OFF_WGI) + (size_t)k2 * 4096 * 1024, 4096, 1024, e);
            LSYNC();
            TCAT(6); gm_gate_phase(a, vb, k2, lds);
            A2 = ACT; B2 = (const bf16_t*)(a.ws + OFF_WGO) + (size_t)k2 * 1024 * 2048; K2 = 2048;
            LSYNC();
        }
        TCAT(0);
        { EpiOutSsq e; e.O = (si & 1) ? (bf16_t*)(a.ws + OFF_O2) : O; e.ssq = (si & 1) ? (float*)(a.ws + OFF_SSQ2) : SSQ; run_gemm(lds, cg_, A2, REGB, B2, 1024, K2, e); }
        LSYNC();
        TCAT(1); ew_phase(a, vb, si, si < 11 ? si + 1 : -1, (si & 1) ? 2 : 1, si <= 1 ? a.x : a.out, a.out, H);
        LSYNC();
    }
#ifdef TPROBE
    {
        float* TM = (float*)(a.ws + OFF_C2);
        if (vb == 0 && threadIdx.x == 0) TM[0] = (float)tacc * 0.01f * TSCALE;
        xcd_barrier(xb);
        const float eps_ = TM[0];
        for (int r = 0; r < 128; ++r) { float* p = a.out + (size_t)(vb * 128 + r) * D; for (int c_ = threadIdx.x; c_ < D; c_ += 512) p[c_] *= (1.0f + eps_); }
    }
#endif
}

extern "C" void kernel_launch(void* const* d_in, const int* in_sizes, int n_in, void* d_out, int out_size, void* d_ws, size_t ws_size, hipStream_t stream) {
    static int grid_blocks = 0;
    if (grid_blocks == 0) {
        if (n_in != 23 || out_size != T * D || ws_size < WS_END) { fprintf(stderr, "kernel_launch: unexpected shapes (n_in %d out %d ws %zu need %zu)\n", n_in, out_size, ws_size, (size_t)WS_END); grid_blocks = -1; return; }
        int dev = 0, cus = 0, per_cu = 0;
        hipGetDevice(&dev);
        hipDeviceGetAttribute(&cus, hipDeviceAttributeMultiprocessorCount, dev);
        if (hipFuncSetAttribute((const void*)fwd_megakernel, hipFuncAttributeMaxDynamicSharedMemorySize, LDS_BYTES) != hipSuccess) { fprintf(stderr, "kernel_launch: hipFuncSetAttribute failed\n"); (void)hipGetLastError(); }
        if (hipOccupancyMaxActiveBlocksPerMultiprocessor(&per_cu, (const void*)fwd_megakernel, 512, LDS_BYTES) != hipSuccess || per_cu < 1) { fprintf(stderr, "kernel_launch: occupancy query gave %d\n", per_cu); (void)hipGetLastError(); per_cu = 1; }
        grid_blocks = cus * 1;
        if (grid_blocks <= 0) grid_blocks = 256;
    }
    if (grid_blocks < 0) return;
    Args a{};
    const float** ap = (const float**)&a;
    for (int i = 0; i < 23; ++i) ap[i] = (const float*)d_in[i];
    a.out = (float*)d_out; a.ws = (unsigned char*)d_ws;
    if (hipMemsetAsync((unsigned char*)d_ws + OFF_BAR, 0, WS_END - OFF_BAR, stream) != hipSuccess) { fprintf(stderr, "kernel_launch: memset failed\n"); return; }
    void* args[] = {&a};
    hipError_t e = hipLaunchCooperativeKernel((const void*)fwd_megakernel, dim3(grid_blocks), dim3(512), args, LDS_BYTES, stream);
    if (e != hipSuccess) fprintf(stderr, "cooperative launch failed: %s (grid %d)\n", hipGetErrorString(e), grid_blocks);
}
```

```cpp
#include <hip/hip_runtime.h>
#include <hip/hip_cooperative_groups.h>
#include <cstdio>
namespace cg = cooperative_groups;
namespace pg8 {
#define PG8_LAS __attribute__((address_space(3)))
typedef unsigned short bf16_t;
typedef short bf16x8 __attribute__((ext_vector_type(8)));
typedef float f32x4 __attribute__((ext_vector_type(4)));
typedef unsigned u32x4 __attribute__((ext_vector_type(4)));
constexpr int BM = 256, BK = 64, HALF = 128, HTB = HALF * BK * 2  , STAGE_BYTES = 8 * HTB, NXCD = 8, WGM = 8;

__host__ __device__ __forceinline__ int lds_byte(int r, int c) { const int st = (r >> 4) * 2 + (c >> 5), rr = r & 15, cc = c & 31, ob = rr * 64 + cc * 2; return st * 1024 + (ob ^ (((ob >> 9) & 1) << 5)); }
__host__ __device__ __forceinline__ void stage_rc(int b, int& R, int& C) { const int st = b / 1024, sb = b % 1024, swz = sb ^ (((sb >> 9) & 1) << 5); R = (st >> 1) * 16 + swz / 64; C = (st & 1) * 32 + (swz % 64) / 2; }
__host__ __device__ __forceinline__ int perm32(int rho) { const int n = rho >> 4, i = rho & 15; return 8 * (i >> 2) + 4 * n + (i & 3); }

struct Unit { int pm, pn; };
struct Gemm { const bf16_t* A; const bf16_t* Bt; int M, N, K; size_t ars; };

struct StaticOrder {
    int nM, nN, nwg, G, c;
    __host__ __device__ void init(int M, int N, int G_, int c_) { nM = M / BM; nN = N / BM; nwg = nM * nN; G = G_; c = c_; }
    __host__ __device__ bool next(int i, Unit& u) const {
        const long L = (long)i * G + c; if (L >= nwg) return false;
        int wgid = (int)L; { const int q = nwg / NXCD, r = nwg % NXCD, xcd = wgid % NXCD, off = wgid / NXCD; wgid = (xcd < r ? xcd * (q + 1) : r * (q + 1) + (xcd - r) * q) + off; }
        const int nig = WGM * nN, gid = wgid / nig, fm = gid * WGM, gsz = (nM - fm) < WGM ? (nM - fm) : WGM;
        u.pm = fm + ((wgid % nig) % gsz); u.pn = (wgid % nig) / gsz; return true;
    }
    __device__ __forceinline__ void a_ready(const Unit&) const {}
    __device__ __forceinline__ void done(const Unit&) const {}
};
__device__ __forceinline__ unsigned cvt_pk_bf16(float lo, float hi) { unsigned r; asm volatile("v_cvt_pk_bf16_f32 %0, %1, %2" : "=v"(r) : "v"(lo), "v"(hi)); return r; }
template <class Epi, class Sched, bool STAMP = false>
__device__ __forceinline__ void gemm_phase(PG8_LAS unsigned char* lds, const Gemm g, const Sched& S, const Epi& E, unsigned long long* stamps) {
    int tid_ = threadIdx.x; asm volatile("" : "+v"(tid_)); const int tid = tid_, wid = __builtin_amdgcn_readfirstlane(tid >> 6), lane = tid & 63, wr = wid >> 2, wc = wid & 3, fr = lane & 15, fq = lane >> 4;
    const int K = g.K, nt = K / BK;
    int ts_lo = 0, ts_hi = 0, nts = 0; const unsigned long long rt_entry = STAMP ? (unsigned long long)wall_clock64() : 0ull;
#define PG8_STAMP() do { if (STAMP && wid == 0 && nts < 64) { const unsigned long long _c = (unsigned long long)clock64(); \
        ts_lo = (lane == nts) ? (int)(unsigned)_c : ts_lo; ts_hi = (lane == nts) ? (int)(unsigned)(_c >> 32) : ts_hi; ++nts; } } while (0)
    PG8_STAMP();
    unsigned voffA[2], voffB[2];
#pragma unroll
    for (int i = 0; i < 2; ++i) { int R, C; stage_rc(tid * 16 + i * 8192, R, C); const int Rb = Epi::PERM ? ((R & ~31) + perm32(R & 31)) : R;
        voffA[i] = (unsigned)(R * K + C) * 2u; voffB[i] = (unsigned)(Rb * K + C) * 2u; }
    const size_t kstep = (size_t)(BK * 2);
    const size_t hstep = (size_t)HALF * K * 2;
    const size_t tstep = 2 * hstep;
    const unsigned ldsw = (unsigned)wid * 1024u;
    const int aoff = lds_byte(wr * 64 + fr, fq * 8), boff = lds_byte(wc * 32 + fr, fq * 8);
#define PG8_SA(b, h) (((b) * 2 + (h)) * HTB)
#define PG8_SB(b, h) ((4 + (b) * 2 + (h)) * HTB)
#define PG8_STAGE(bufoff, gbase, voff) do { _Pragma("unroll") for (int _i = 0; _i < 2; ++_i) \
        __builtin_amdgcn_global_load_lds((const unsigned*)((const char*)(gbase) + (voff)[_i]), (PG8_LAS unsigned*)(lds + (bufoff) + ldsw + _i * 8192), 16, 0, 0); } while (0)
#define PG8_LDA(dst, b, h) do { _Pragma("unroll") for (int m = 0; m < 4; ++m) _Pragma("unroll") for (int k = 0; k < 2; ++k) dst[m][k] = *(const PG8_LAS bf16x8*)(lds + PG8_SA(b, h) + aoff + m * 2048 + k * 1024); } while (0)
#define PG8_LDB(dst, b, h) do { _Pragma("unroll") for (int n = 0; n < 2; ++n) _Pragma("unroll") for (int k = 0; k < 2; ++k) dst[n][k] = *(const PG8_LAS bf16x8*)(lds + PG8_SB(b, h) + boff + n * 2048 + k * 1024); } while (0)
#define PG8_MMA(ai, bj, At, Bt) do { __builtin_amdgcn_s_setprio(1); _Pragma("unroll") for (int m = 0; m < 4; ++m) _Pragma("unroll") for (int n = 0; n < 2; ++n) _Pragma("unroll") for (int k = 0; k < 2; ++k) \
        acc[ai][bj][m][n] = __builtin_amdgcn_mfma_f32_16x16x32_bf16(Bt[n][k], At[m][k], acc[ai][bj][m][n], 0, 0, 0); __builtin_amdgcn_s_setprio(0); } while (0)
#define PG8_WAIT_V(n) asm volatile("s_waitcnt vmcnt(" #n ")" ::: "memory")
#define PG8_WAIT_L(n) asm volatile("s_waitcnt lgkmcnt(" #n ")" ::: "memory")
#define PG8_BAR __builtin_amdgcn_s_barrier()
#define PG8_SCHED __builtin_amdgcn_sched_barrier(0)
    Unit cur, nxt; int ui = 0;
    if (!S.next(0, cur)) return;
    f32x4 acc[2][2][4][2];
#pragma unroll
    for (int a = 0; a < 2; ++a)
#pragma unroll
        for (int b = 0; b < 2; ++b)
#pragma unroll
            for (int m = 0; m < 4; ++m)
#pragma unroll
                for (int n = 0; n < 2; ++n) acc[a][b][m][n] = (f32x4){0.f, 0.f, 0.f, 0.f};
    bf16x8 At[4][2], B0[2][2], B1[2][2];
    const char* cA = (const char*)g.A + (size_t)(cur.pm >> 4) * g.ars + (size_t)(cur.pm & 15) * tstep; const char* cB = (const char*)g.Bt + (size_t)cur.pn * tstep;
    S.a_ready(cur);
    PG8_STAGE(PG8_SB(0, 0), cB, voffB); PG8_STAGE(PG8_SA(0, 0), cA, voffA); PG8_STAGE(PG8_SB(0, 1), cB + hstep, voffB); PG8_STAGE(PG8_SA(0, 1), cA + hstep, voffA);
    if (wr == 1) PG8_BAR;
    PG8_WAIT_V(4); PG8_BAR;
    PG8_STAGE(PG8_SB(1, 0), cB + kstep, voffB); PG8_STAGE(PG8_SA(1, 0), cA + kstep, voffA); PG8_STAGE(PG8_SB(1, 1), cB + hstep + kstep, voffB);
    PG8_WAIT_V(6); PG8_BAR;
    PG8_STAMP();
    for (;;) {
        const bool has_next = S.next(ui + 1, nxt);
        const char* nA = has_next ? (const char*)g.A + (size_t)(nxt.pm >> 4) * g.ars + (size_t)(nxt.pm & 15) * tstep : cA; const char* nB = has_next ? (const char*)g.Bt + (size_t)nxt.pn * tstep : cB;
        for (int t = 0; t < nt; t += 2) {
            const bool last = (t == nt - 2);
            const char* a1 = cA + (size_t)(t + 1) * kstep;
            const char* a2 = last ? nA : cA + (size_t)(t + 2) * kstep; const char* b2 = last ? nB : cB + (size_t)(t + 2) * kstep;
            const char* a3 = a2 + kstep; const char* b3 = b2 + kstep;
            if (last && has_next) S.a_ready(nxt);
            PG8_LDB(B0, 0, 0); PG8_SCHED; PG8_LDA(At, 0, 0); PG8_STAGE(PG8_SA(1, 1), a1 + hstep, voffA);
            PG8_WAIT_L(8); PG8_BAR; PG8_WAIT_L(0); PG8_MMA(0, 0, At, B0); PG8_BAR; PG8_SCHED;
            PG8_LDB(B1, 0, 1); PG8_STAGE(PG8_SB(0, 0), b2, voffB);
            PG8_BAR; PG8_WAIT_L(0); PG8_MMA(0, 1, At, B1); PG8_BAR;
            PG8_LDA(At, 0, 1); PG8_STAGE(PG8_SA(0, 0), a2, voffA);
            PG8_BAR; PG8_WAIT_L(0); PG8_MMA(1, 0, At, B0); PG8_BAR; PG8_SCHED;
            PG8_STAGE(PG8_SB(0, 1), b2 + hstep, voffB);
            PG8_WAIT_V(6); PG8_BAR; PG8_MMA(1, 1, At, B1); PG8_BAR;
            PG8_LDB(B0, 1, 0); PG8_SCHED; PG8_LDA(At, 1, 0); PG8_STAGE(PG8_SA(0, 1), a2 + hstep, voffA);
            PG8_WAIT_L(8); PG8_BAR; PG8_WAIT_L(0); PG8_MMA(0, 0, At, B0); PG8_BAR; PG8_SCHED;
            PG8_LDB(B1, 1, 1); PG8_STAGE(PG8_SB(1, 0), b3, voffB);
            PG8_BAR; PG8_WAIT_L(0); PG8_MMA(0, 1, At, B1); PG8_BAR;
            PG8_LDA(At, 1, 1); PG8_STAGE(PG8_SA(1, 0), a3, voffA);
            PG8_BAR; PG8_WAIT_L(0); PG8_MMA(1, 0, At, B0); PG8_BAR; PG8_SCHED;
            PG8_STAGE(PG8_SB(1, 1), b3 + hstep, voffB);
            PG8_WAIT_V(6); PG8_BAR; PG8_MMA(1, 1, At, B1); PG8_BAR;
        }
        PG8_STAMP();
        if constexpr (!Epi::AFTER_DRAIN) { E(acc, cur, wr, wc, fr, fq); S.done(cur); }
        PG8_STAMP();
        if (!has_next) break;
#pragma unroll
        for (int a = 0; a < 2; ++a)
#pragma unroll
            for (int b = 0; b < 2; ++b)
#pragma unroll
                for (int m = 0; m < 4; ++m)
#pragma unroll
                    for (int n = 0; n < 2; ++n) acc[a][b][m][n] = (f32x4){0.f, 0.f, 0.f, 0.f};
        cur = nxt; cA = nA; cB = nB; ++ui;
    }
    PG8_WAIT_V(0);
    if (wr == 0) PG8_BAR;
    PG8_BAR;
    if constexpr (Epi::AFTER_DRAIN) { E.fused(acc, cur, wr, wc, fr, fq, lds, wid, lane); S.done(cur); }
    PG8_STAMP();
    if (STAMP && wid == 0) { stamps[lane] = lane < nts ? (((unsigned long long)(unsigned)ts_hi << 32) | (unsigned)ts_lo) : 0ull;
        if (lane == 62) stamps[62] = rt_entry; if (lane == 63) stamps[63] = (unsigned long long)wall_clock64(); }
#undef PG8_STAMP
#undef PG8_SA
#undef PG8_SB
#undef PG8_STAGE
#undef PG8_LDA
#undef PG8_LDB
#undef PG8_MMA
#undef PG8_WAIT_V
#undef PG8_WAIT_L
#undef PG8_BAR
#undef PG8_SCHED
}
}
#define LAS PG8_LAS
#define XB_TMO      128
#define XB_XCNT(j)  (256  + 64 * (j))
#define XB_XSUB(j)  (1280 + 64 * (j))
#define XB_XGEN(j)  (2304 + 64 * (j))
#define XB_TOP      3328
#define XB_TOPGEN   3392
#define XCD_BAR_WORDS 3456
#define XB_SPIN_CAP (1u << 18)

__device__ __forceinline__ unsigned xb_ld(unsigned* p)              { return __hip_atomic_load(p, __ATOMIC_RELAXED, __HIP_MEMORY_SCOPE_AGENT); }
__device__ __forceinline__ unsigned xb_add(unsigned* p, unsigned v) { return __hip_atomic_fetch_add(p, v, __ATOMIC_RELAXED, __HIP_MEMORY_SCOPE_AGENT); }
__device__ __forceinline__ unsigned xb_xcc_id() { return (unsigned)__builtin_amdgcn_s_getreg((3 << 11) | 20) & 0xFu; }
#define XB_SPIN(cond, bar) do { unsigned _sp = 0; while (cond) { __builtin_amdgcn_s_sleep(1); \
    if ((++_sp & 255u) == 0u) { if (xb_ld(&(bar)[XB_TMO])) break; if (_sp > XB_SPIN_CAP) { atomicAdd(&(bar)[XB_TMO], 1u); break; } } } } while (0)

struct XcdBarrier {
    unsigned* bar; unsigned x;
    volatile LAS unsigned* st;
};

__device__ __forceinline__ XcdBarrier xcd_barrier_post(unsigned* bar, volatile LAS unsigned* st) {
    XcdBarrier b; b.bar = bar; b.x = xb_xcc_id(); b.st = st;
    if (threadIdx.x == 0) (void)xb_add(&bar[XB_XCNT(b.x)], 1u);
    return b;
}
__device__ __forceinline__ void xcd_barrier_complete(unsigned* bar, unsigned x, unsigned& nloc, unsigned& nx) {
    const unsigned G = gridDim.x * gridDim.y * gridDim.z;
    unsigned sum, cnt, mine, sp = 0u;
    for (;;) {
        sum = 0u; cnt = 0u; mine = 0u;
#pragma unroll
        for (unsigned j = 0; j < 16; ++j) { const unsigned c = xb_ld(&bar[XB_XCNT(j)]); sum += c; cnt += (c > 0u) ? 1u : 0u; mine = (j == x) ? c : mine; }
        if (sum == G) break;
        __builtin_amdgcn_s_sleep(1);
        if ((++sp & 255u) == 0u) { if (xb_ld(&bar[XB_TMO])) break; if (sp > XB_SPIN_CAP) { atomicAdd(&bar[XB_TMO], 1u); break; } }
    }
    nloc = mine > 0u ? mine : 1u; nx = cnt > 0u ? cnt : 1u;
}

__device__ __forceinline__ void xcd_barrier(const XcdBarrier& b) {
    asm volatile("s_waitcnt vmcnt(0)" ::: "memory");
    __syncthreads();
    if (threadIdx.x == 0) {
        unsigned* bar = b.bar;
        __builtin_amdgcn_s_waitcnt(0);
        unsigned nloc = b.st[0], nx = b.st[1];
        if (nloc == 0u) { xcd_barrier_complete(bar, b.x, nloc, nx); b.st[0] = nloc; b.st[1] = nx; }
        const unsigned old = xb_add(&bar[XB_XSUB(b.x)], 1u);
        const unsigned gen = old / nloc;
        if (old + 1u == (gen + 1u) * nloc) {
            __builtin_amdgcn_fence(__ATOMIC_RELEASE, "agent");
            asm volatile("s_waitcnt vmcnt(0)" ::: "memory");
            const unsigned og = xb_add(&bar[XB_TOP], 1u);
            const unsigned tg = og / nx;
            if (og + 1u == (tg + 1u) * nx) xb_add(&bar[XB_TOPGEN], 1u);
            else XB_SPIN(xb_ld(&bar[XB_TOPGEN]) == tg, bar);
            __builtin_amdgcn_fence(__ATOMIC_ACQUIRE, "agent");
            xb_add(&bar[XB_XGEN(b.x)], 1u);
            asm volatile("s_waitcnt vmcnt(0)" ::: "memory");
        } else {
            XB_SPIN(xb_ld(&bar[XB_XGEN(b.x)]) == gen, bar);
            __builtin_amdgcn_fence(__ATOMIC_ACQUIRE, "agent");
            asm volatile("s_waitcnt vmcnt(0)" ::: "memory");
        }
    }
    __syncthreads();
}

using namespace pg8;
#define LAS PG8_LAS
typedef unsigned u32x2 __attribute__((ext_vector_type(2)));

constexpr int T = 32768, D = 1024, SEQ = 16384, DFF = 2816, NMOD = 9216;
constexpr float EPS = 1e-6f;
constexpr int LDS_BYTES = 147456;

constexpr size_t OFF_MOD = 0;
constexpr size_t OFF_C2 = OFF_MOD + 294912;
constexpr size_t OFF_SSQ = OFF_C2 + 8192;
constexpr size_t OFF_VSTAT = OFF_SSQ + 2097152;
constexpr size_t OFF_CHA = OFF_VSTAT + 8388608;
constexpr size_t OFF_CHH = OFF_CHA + 1048576;
constexpr size_t OFF_WFI = OFF_CHH + 1048576;
constexpr size_t OFF_WFO = OFF_WFI + 92274688;
constexpr size_t OFF_WRI = OFF_WFO + 46137344;
constexpr size_t OFF_WRG = OFF_WRI + 8388608;
constexpr size_t OFF_WRO = OFF_WRG + 1048576;
constexpr size_t OFF_WGI = OFF_WRO + 4194304;
constexpr size_t OFF_WGS = OFF_WGI + 16777216;
constexpr size_t OFF_WGO = OFF_WGS + 524288;
constexpr size_t OFF_H = OFF_WGO + 8388608;
constexpr size_t OFF_O = OFF_H + 67108864;
constexpr size_t OFF_ACT = OFF_O + 67108864;
constexpr size_t OFF_BAR = OFF_ACT + 268435456;
constexpr size_t OFF_LOC = OFF_BAR + 16384;
constexpr size_t OFF_NSP = OFF_LOC + 4096;
constexpr size_t OFF_O2 = OFF_NSP + 8192;
constexpr size_t OFF_SSQ2 = OFF_O2 + 67108864;
constexpr size_t WS_END = OFF_SSQ2 + 2097152;
constexpr size_t REGB = 33554432;

struct Args {
    const float *x, *c, *ada_w, *ada_b, *norm_pre, *norm_post, *ffn_w_in, *ffn_w_out, *rg_w_in, *rg_conv_w, *rg_conv_b, *rg_w_a, *rg_b_a, *rg_w_x, *rg_b_x, *rg_lambda,
        *rg_w_out, *gm_w_in, *gm_ln_g, *gm_ln_b, *gm_w_s, *gm_b_s, *gm_w_out;
    float* out; unsigned char* ws;
};

__device__ __forceinline__ float bf_lo(unsigned w) { return __uint_as_float(w << 16); }
__device__ __forceinline__ float bf_hi(unsigned w) { return __uint_as_float(w & 0xffff0000u); }
__device__ __forceinline__ bf16_t f2bf(float f) { unsigned u = __float_as_uint(f); u += 0x7FFFu + ((u >> 16) & 1u); return (bf16_t)(u >> 16); }
__device__ __forceinline__ float sigm(float x) { return __builtin_amdgcn_rcpf(1.0f + __expf(-x)); }
__device__ __forceinline__ float silu_f(float x) { return x * sigm(x); }
__device__ __forceinline__ float gelu_t(float x) { const float t = x * fmaf(-0.10294324f, x * x, -2.3022082f); return x * __builtin_amdgcn_rcpf(1.0f + __builtin_amdgcn_exp2f(t)); }
__device__ __forceinline__ u32x4 pack8(const f32x4 a, const f32x4 b) { u32x4 w; w.x = cvt_pk_bf16(a[0], a[1]); w.y = cvt_pk_bf16(a[2], a[3]); w.z = cvt_pk_bf16(b[0], b[1]); w.w = cvt_pk_bf16(b[2], b[3]); return w; }
__device__ __forceinline__ void unpack8(const u32x4 w, float (&f)[8]) { f[0] = bf_lo(w.x); f[1] = bf_hi(w.x); f[2] = bf_lo(w.y); f[3] = bf_hi(w.y); f[4] = bf_lo(w.z); f[5] = bf_hi(w.z); f[6] = bf_lo(w.w); f[7] = bf_hi(w.w); }

__device__ __forceinline__ size_t act_off(int row, int pitchB, size_t sub) { return (size_t)(row >> 12) * REGB + sub + (size_t)(row & 4095) * (size_t)pitchB; }
__device__ __forceinline__ void xcc_local_barrier(unsigned* cnt, unsigned nloc) {
    asm volatile("s_waitcnt vmcnt(0)" ::: "memory");
    __syncthreads();
    if (threadIdx.x == 0) {
        __builtin_amdgcn_s_waitcnt(0);
        const unsigned old = xb_add(cnt, 1u); const unsigned target = (old / nloc + 1u) * nloc; unsigned sp = 0u;
        while (xb_ld(cnt) < target) { __builtin_amdgcn_s_sleep(1); if (++sp > (1u << 20)) break; }
        __builtin_amdgcn_fence(__ATOMIC_ACQUIRE, "agent");
        asm volatile("s_waitcnt vmcnt(0)" ::: "memory");
    }
    __syncthreads();
}

struct EpiSwiglu {
    static constexpr bool PERM = true, AFTER_DRAIN = false;
    bf16_t* O;
    __device__ __forceinline__ void operator()(const f32x4 (&acc)[2][2][4][2], const Unit& u, int wr, int wc, int fr, int fq) const {
        const int row0 = u.pm * BM + wr * 64 + fr, col0 = u.pn * 128 + wc * 32 + 8 * fq;
#pragma unroll
        for (int ai = 0; ai < 2; ++ai)
#pragma unroll
            for (int m = 0; m < 4; ++m) {
                f32x4 v0, v1;
#pragma unroll
                for (int j = 0; j < 4; ++j) { v0[j] = silu_f(acc[ai][0][m][0][j]) * acc[ai][1][m][0][j]; v1[j] = silu_f(acc[ai][0][m][1][j]) * acc[ai][1][m][1][j]; }
                *(u32x4*)((unsigned char*)O + act_off(row0 + ai * HALF + m * 16, DFF * 2, 0) + (size_t)col0 * 2) = pack8(v0, v1);
            }
    }
};
struct EpiOutSsq {
    static constexpr bool PERM = true, AFTER_DRAIN = false;
    bf16_t* O; float* ssq;
    __device__ __forceinline__ void operator()(const f32x4 (&acc)[2][2][4][2], const Unit& u, int wr, int wc, int fr, int fq) const {
        const int row0 = u.pm * BM + wr * 64 + fr, col0 = u.pn * BM + wc * 32 + 8 * fq;
#pragma unroll
        for (int ai = 0; ai < 2; ++ai)
#pragma unroll
            for (int m = 0; m < 4; ++m) {
                const int row = row0 + ai * HALF + m * 16; float s = 0.f;
#pragma unroll
                for (int bj = 0; bj < 2; ++bj) { const f32x4 v0 = acc[ai][bj][m][0], v1 = acc[ai][bj][m][1];
                    s += (v0[0] * v0[0] + v0[1] * v0[1]) + (v0[2] * v0[2] + v0[3] * v0[3]) + (v1[0] * v1[0] + v1[1] * v1[1]) + (v1[2] * v1[2] + v1[3] * v1[3]);
                    *(u32x4*)(O + (size_t)row * D + col0 + bj * HALF) = pack8(v0, v1); }
                s += __shfl_xor(s, 16); s += __shfl_xor(s, 32);
                if (fq == 0) ssq[(size_t)row * 16 + u.pn * 4 + wc] = s;
            }
    }
};
template <int GELU> struct EpiSplit {
    static constexpr bool PERM = true, AFTER_DRAIN = false;
    bf16_t* O0; bf16_t* O1; int half; float* vstat;
    __device__ __forceinline__ void operator()(const f32x4 (&acc)[2][2][4][2], const Unit& u, int wr, int wc, int fr, int fq) const {
        int colt = u.pn * BM; const bool second = colt >= half; if (second) colt -= half; const size_t sub = second ? (size_t)4096 * half * 2 : 0;
        const int row0 = u.pm * BM + wr * 64 + fr, col0 = colt + wc * 32 + 8 * fq; const int vt = colt >> 8;
#pragma unroll
        for (int ai = 0; ai < 2; ++ai)
#pragma unroll
            for (int m = 0; m < 4; ++m) {
                const int row = row0 + ai * HALF + m * 16; float s = 0.f, q = 0.f;
#pragma unroll
                for (int bj = 0; bj < 2; ++bj) { f32x4 v0 = acc[ai][bj][m][0], v1 = acc[ai][bj][m][1];
                    if (GELU) {
#pragma unroll
                        for (int j = 0; j < 4; ++j) { v0[j] = gelu_t(v0[j]); v1[j] = gelu_t(v1[j]); }
                        if (second) {
                        s += (v0[0] + v0[1]) + (v0[2] + v0[3]) + (v1[0] + v1[1]) + (v1[2] + v1[3]);
                        q += (v0[0] * v0[0] + v0[1] * v0[1]) + (v0[2] * v0[2] + v0[3] * v0[3]) + (v1[0] * v1[0] + v1[1] * v1[1]) + (v1[2] * v1[2] + v1[3] * v1[3]); } }
                    *(u32x4*)((unsigned char*)O0 + act_off(row, half * 2, sub) + (size_t)(col0 + bj * HALF) * 2) = pack8(v0, v1); }
                if (GELU && second) { s += __shfl_xor(s, 16); s += __shfl_xor(s, 32); q += __shfl_xor(q, 16); q += __shfl_xor(q, 32);
                    if (fq == 0) { float* p = vstat + ((size_t)row * 32 + vt * 4 + wc) * 2; p[0] = s; p[1] = q; } }
            }
    }
};

__device__ __forceinline__ void prep_phase(const Args& a, LAS unsigned char* lds) {
    int tid_ = threadIdx.x; asm volatile("" : "+v"(tid_)); const int tid = tid_, wid = tid >> 6, lane = tid & 63;
    float* MOD = (float*)(a.ws + OFF_MOD);
    {
        LAS float* sc = (LAS float*)lds;
        LAS float* red = sc + 2048;
        for (int i = tid; i < 2048; i += 512) sc[i] = silu_f(a.c[i]);
        __syncthreads();
        for (int it = blockIdx.x; it < 576; it += gridDim.x) {
            const int l = it / 144, nb = it % 144;
            const float* w = a.ada_w + ((size_t)l * 1024 + wid * 128) * NMOD + nb * 64 + lane;
            float a0 = 0.f, a1 = 0.f;
#pragma unroll 16
            for (int k = 0; k < 128; ++k) { const float wv = w[(size_t)k * NMOD]; a0 += sc[wid * 128 + k] * wv; a1 += sc[1024 + wid * 128 + k] * wv; }
            red[(wid * 64 + lane) * 2] = a0; red[(wid * 64 + lane) * 2 + 1] = a1;
            __syncthreads();
            if (tid < 128) { const int ln = tid & 63, b = tid >> 6; float s = 0.f;
#pragma unroll
                for (int w2 = 0; w2 < 8; ++w2) s += red[(w2 * 64 + ln) * 2 + b];
                MOD[(size_t)(l * 2 + b) * NMOD + nb * 64 + ln] = s + a.ada_b[(size_t)l * NMOD + nb * 64 + ln]; }
            __syncthreads();
        }
    }
    {
        LAS float* L = (LAS float*)lds;
        const bool bal = (gridDim.x == 256);
        const int tbeg = bal ? ((int)blockIdx.x < 64 ? (int)blockIdx.x * 18 : 1152 + ((int)blockIdx.x - 64) * 22) : (int)blockIdx.x;
        const int tend = bal ? tbeg + ((int)blockIdx.x < 64 ? 18 : 22) : 5376, tinc = bal ? 1 : (int)gridDim.x;
#define PREP_DECODE(tix_) \
            int t = (tix_), K, N, mode = 0; const float* src; bf16_t* dst; \
            if (t < 2816) { const int mi = t / 352; t %= 352; src = a.ffn_w_in + (size_t)mi * 1024 * 5632; dst = (bf16_t*)(a.ws + OFF_WFI) + (size_t)mi * 5632 * 1024; K = 1024; N = 5632; mode = 1; } \
            else if ((t -= 2816) < 1408) { const int mi = t / 176; t %= 176; src = a.ffn_w_out + (size_t)mi * 2816 * 1024; dst = (bf16_t*)(a.ws + OFF_WFO) + (size_t)mi * 1024 * 2816; K = 2816; N = 1024; } \
            else if ((t -= 1408) < 256) { const int mi = t / 128; t %= 128; src = a.rg_w_in + (size_t)mi * 1024 * 2048; dst = (bf16_t*)(a.ws + OFF_WRI) + (size_t)mi * 2048 * 1024; K = 1024; N = 2048; } \
            else if ((t -= 256) < 128) { const int mi = t / 64; t %= 64; src = a.rg_w_out + (size_t)mi * 1024 * 1024; dst = (bf16_t*)(a.ws + OFF_WRO) + (size_t)mi * 1024 * 1024; K = 1024; N = 1024; } \
            else if ((t -= 128) < 512) { const int mi = t / 256; t %= 256; src = a.gm_w_in + (size_t)mi * 1024 * 4096; dst = (bf16_t*)(a.ws + OFF_WGI) + (size_t)mi * 4096 * 1024; K = 1024; N = 4096; } \
            else { t -= 512; const int mi = t / 128; t %= 128; src = a.gm_w_out + (size_t)mi * 2048 * 1024; dst = (bf16_t*)(a.ws + OFF_WGO) + (size_t)mi * 1024 * 2048; K = 2048; N = 1024; } \
            const int ntn = N >> 8, kt = t / ntn, nt = t % ntn, k0 = kt * 64, n0 = nt * 256;
#define PREP_LOAD() _Pragma("unroll") for (int i = 0; i < 8; ++i) { const int idx = tid + 512 * i, row = idx >> 6, c4 = idx & 63; v[i] = *(const f32x4*)(src + (size_t)(k0 + row) * N + n0 + c4 * 4); }
        f32x4 v[8];
        if (tbeg < tend) { PREP_DECODE(tbeg) PREP_LOAD() (void)dst; (void)K; (void)mode; }
        for (int tix = tbeg; tix < tend; tix += tinc) {
#pragma unroll
            for (int i = 0; i < 8; ++i) { const int idx = tid + 512 * i, row = idx >> 6, c4 = idx & 63; *(LAS f32x4*)(L + row * 260 + c4 * 4) = v[i]; }
            if (tix + tinc < tend) { PREP_DECODE(tix + tinc) PREP_LOAD() (void)dst; (void)K; (void)mode; }
            __syncthreads();
            PREP_DECODE(tix)
            (void)src; (void)ntn; (void)kt; (void)nt;
            const int n = tid & 255, kh = tid >> 8, c = n0 + n; int drow = c;
            if (mode == 1) { const int up = c >= 2816, cc = up ? c - 2816 : c; drow = (cc >> 7) * 256 + up * 128 + (cc & 127); }
            bf16_t* dp = dst + (size_t)drow * K + k0 + kh * 32;
#pragma unroll
            for (int p = 0; p < 4; ++p) { f32x4 f0, f1;
#pragma unroll
                for (int j = 0; j < 4; ++j) { f0[j] = L[(kh * 32 + p * 8 + j) * 260 + n]; f1[j] = L[(kh * 32 + p * 8 + 4 + j) * 260 + n]; }
                *(u32x4*)(dp + p * 8) = pack8(f0, f1); }
            __syncthreads();
        }
#undef PREP_DECODE
#undef PREP_LOAD
    }
    {
        bf16_t* WRG = (bf16_t*)(a.ws + OFF_WRG);
        for (int idx = blockIdx.x * 512 + tid; idx < 524288; idx += gridDim.x * 512) {
            const int d = idx & 127, e = (idx >> 7) & 127, which = (idx >> 14) & 1, h = (idx >> 15) & 7, k2 = idx >> 18;
            const float* s = (which ? a.rg_w_x : a.rg_w_a) + (((size_t)(k2 * 8 + h) * 128 + d) * 128 + e);
            WRG[idx] = f2bf(*s);
        }
    }
    {
        float* NSP = (float*)(a.ws + OFF_NSP);
        for (int i = blockIdx.x * 512 + tid; i < 2048; i += gridDim.x * 512) NSP[i] = -8.0f * log1pf(expf(-a.rg_lambda[i])) * 1.4426950408889634f;
    }
    {
        bf16_t* WGS = (bf16_t*)(a.ws + OFF_WGS); float* C2 = (float*)(a.ws + OFF_C2);
        for (int row = blockIdx.x * 8 + wid; row < 2048; row += gridDim.x * 8) {
            const int t = row & 127; float sum = 0.f;
#pragma unroll
            for (int s = lane; s < 128; s += 64) { float w = a.gm_w_s[(size_t)row * 128 + s]; if (s > t) w = 0.f; WGS[(size_t)row * 128 + s] = f2bf(w); sum += w; }
#pragma unroll
            for (int o = 32; o >= 1; o >>= 1) sum += __shfl_xor(sum, o);
            if (lane == 0) C2[row] = sum;
        }
    }
}

__device__ __forceinline__ void ew_phase(const Args& a, int vb, int sp, int sn, int wm, const float* xin, float* xout, bf16_t* H) {
    int tid_ = threadIdx.x; asm volatile("" : "+v"(tid_)); const int tid = tid_, wid = tid >> 6, lane = tid & 63;
    const float* MOD = (const float*)(a.ws + OFF_MOD);
    const float* SSQc = (const float*)(a.ws + ((sp & 1) ? OFF_SSQ2 : OFF_SSQ)); const bf16_t* Oc = (const bf16_t*)(a.ws + ((sp & 1) ? OFF_O2 : OFF_O));
    const float* SSQp = (const float*)(a.ws + OFF_SSQ); const bf16_t* Op = (const bf16_t*)(a.ws + OFF_O);
    for (int rb = vb * 8 + wid; rb < T / 16; rb += gridDim.x * 8) {
        const int row0 = rb * 16, b = row0 >> 14;
        f32x4 pg[4], pgp[4], ps[4], pb[4];
#pragma unroll
        for (int k = 0; k < 4; ++k) { pg[k] = (f32x4){0.f, 0.f, 0.f, 0.f}; pgp[k] = pg[k]; ps[k] = pg[k]; pb[k] = pg[k]; }
        if (sp >= 0) { const int l = sp / 3, j = sp % 3; const float resw = (j == 1) ? 1.0f : 0.5f;
            const float* gate = MOD + (size_t)(l * 2 + b) * NMOD + j * 3072 + 2048 + 4 * lane; const float* gp = a.norm_post + (size_t)(l * 3 + j) * D + 4 * lane;
#pragma unroll
            for (int k = 0; k < 4; ++k) pg[k] = resw * (*(const f32x4*)(gate + 256 * k)) * (*(const f32x4*)(gp + 256 * k)); }
        if (wm == 2) { const int s2 = sp - 1, l = s2 / 3, j = s2 % 3; const float resw = (j == 1) ? 1.0f : 0.5f;
            const float* gate = MOD + (size_t)(l * 2 + b) * NMOD + j * 3072 + 2048 + 4 * lane; const float* gp = a.norm_post + (size_t)(l * 3 + j) * D + 4 * lane;
#pragma unroll
            for (int k = 0; k < 4; ++k) pgp[k] = resw * (*(const f32x4*)(gate + 256 * k)) * (*(const f32x4*)(gp + 256 * k)); }
        if (sn >= 0) { const int l = sn / 3, j = sn % 3;
            const float* shift = MOD + (size_t)(l * 2 + b) * NMOD + j * 3072 + 4 * lane; const float* gpre = a.norm_pre + (size_t)(l * 3 + j) * D + 4 * lane;
#pragma unroll
            for (int k = 0; k < 4; ++k) { ps[k] = (*(const f32x4*)(gpre + 256 * k)) * (1.0f + *(const f32x4*)(shift + 1024 + 256 * k)); pb[k] = *(const f32x4*)(shift + 256 * k); } }
        f32x4 xn[4]; u32x2 on[4], opn[4]; float sn_ = 0.f, spn_ = 0.f;
#pragma unroll
        for (int k = 0; k < 4; ++k) { on[k] = (u32x2){0u, 0u}; opn[k] = on[k]; }
#define EW_LOADROW(rowi) do { const size_t ro_ = (size_t)(rowi) * D + 4 * lane; \
            _Pragma("unroll") for (int k = 0; k < 4; ++k) xn[k] = __builtin_nontemporal_load((const f32x4*)(xin + ro_ + 256 * k)); \
            if (sp >= 0) { sn_ = SSQc[(size_t)(rowi) * 16 + (lane & 15)]; \
                _Pragma("unroll") for (int k = 0; k < 4; ++k) on[k] = *(const u32x2*)(Oc + ro_ + 256 * k); } \
            if (wm == 2) { spn_ = SSQp[(size_t)(rowi) * 16 + (lane & 15)]; \
                _Pragma("unroll") for (int k = 0; k < 4; ++k) opn[k] = *(const u32x2*)(Op + ro_ + 256 * k); } } while (0)
        EW_LOADROW(row0);
        for (int rr = 0; rr < 16; ++rr) {
            const size_t ro = (size_t)(row0 + rr) * D + 4 * lane;
            f32x4 x[4]; u32x2 oc[4], opc[4]; float s = sn_, s2 = spn_;
#pragma unroll
            for (int k = 0; k < 4; ++k) { x[k] = xn[k]; oc[k] = on[k]; opc[k] = opn[k]; }
            if (rr < 15) EW_LOADROW(row0 + rr + 1);
            if (wm == 2) {
                s2 += __shfl_xor(s2, 1); s2 += __shfl_xor(s2, 2); s2 += __shfl_xor(s2, 4); s2 += __shfl_xor(s2, 8);
                const float rstd2 = rsqrtf(s2 * (1.0f / 1024.0f) + EPS);
#pragma unroll
                for (int k = 0; k < 4; ++k) { const u32x2 ow = opc[k]; const f32x4 o = (f32x4){bf_lo(ow.x), bf_hi(ow.x), bf_lo(ow.y), bf_hi(ow.y)}; x[k] += pgp[k] * (o * rstd2); }
            }
            if (sp >= 0) {
                s += __shfl_xor(s, 1); s += __shfl_xor(s, 2); s += __shfl_xor(s, 4); s += __shfl_xor(s, 8);
                const float rstd = rsqrtf(s * (1.0f / 1024.0f) + EPS);
#pragma unroll
                for (int k = 0; k < 4; ++k) { const u32x2 ow = oc[k]; const f32x4 o = (f32x4){bf_lo(ow.x), bf_hi(ow.x), bf_lo(ow.y), bf_hi(ow.y)};
                    x[k] += pg[k] * (o * rstd); if (wm == 2) __builtin_nontemporal_store(x[k], (f32x4*)(xout + ro + 256 * k)); }
            }
            if (sn >= 0) {
                float ss = 0.f;
#pragma unroll
                for (int k = 0; k < 4; ++k) ss += (x[k][0] * x[k][0] + x[k][1] * x[k][1]) + (x[k][2] * x[k][2] + x[k][3] * x[k][3]);
#pragma unroll
                for (int o = 32; o >= 1; o >>= 1) ss += __shfl_xor(ss, o);
                const float rs = rsqrtf(ss * (1.0f / 1024.0f) + EPS);
#pragma unroll
                for (int k = 0; k < 4; ++k) { const f32x4 hv = (x[k] * rs) * ps[k] + pb[k]; u32x2 w; w.x = cvt_pk_bf16(hv[0], hv[1]); w.y = cvt_pk_bf16(hv[2], hv[3]); *(u32x2*)(H + ro + 256 * k) = w; }
            }
        }
#undef EW_LOADROW
    }
}

__device__ __forceinline__ void rg_scan_phase(const Args& a, int vb, int k2, LAS unsigned char* lds) {
    int tid_ = threadIdx.x; asm volatile("" : "+v"(tid_)); const int tid = tid_, wid = tid >> 6, lane = tid & 63, fr = lane & 15, fq = lane >> 4;
    LAS float* XC = (LAS float*)lds; LAS float* SA = XC + 128 * 132; LAS float* SEG = SA + 128 * 132;
    unsigned char* AB = a.ws + OFF_ACT;
    float* CHA = (float*)(a.ws + OFF_CHA); float* CHH = (float*)(a.ws + OFF_CHH);
    const float* cw = a.rg_conv_w + (size_t)k2 * 4 * D; const float* cb = a.rg_conv_b + (size_t)k2 * D;
    for (int ch = vb; ch < 256; ch += gridDim.x) {
      const int t0 = ch * 128; const bool first = (t0 & (SEQ - 1)) == 0;
      u32x4 xq[7];
#define RG_PF_CONV(hh) do { const int c0_ = (hh) * 128 + (tid & 15) * 8; \
        _Pragma("unroll") for (int r = 0; r < 7; ++r) { const int tt = 4 * (tid >> 4) - 3 + r; \
            if (tt < 0 && first) xq[r] = (u32x4){0u, 0u, 0u, 0u}; else xq[r] = *(const u32x4*)(AB + act_off(t0 + tt, 2048, 0) + (size_t)c0_ * 2); } } while (0)
      RG_PF_CONV(0);
#pragma unroll 1
      for (int h = 0; h < 8; ++h) {
        {
            const int cg8 = tid & 15, tq = tid >> 4, c0 = h * 128 + cg8 * 8;
            float w[4][8], bias[8], xr[7][8];
#pragma unroll
            for (int k = 0; k < 4; ++k) { const f32x4 w0 = *(const f32x4*)(cw + k * D + c0), w1 = *(const f32x4*)(cw + k * D + c0 + 4);
#pragma unroll
                for (int j = 0; j < 4; ++j) { w[k][j] = w0[j]; w[k][4 + j] = w1[j]; } }
            { const f32x4 b0 = *(const f32x4*)(cb + c0), b1 = *(const f32x4*)(cb + c0 + 4);
#pragma unroll
                for (int j = 0; j < 4; ++j) { bias[j] = b0[j]; bias[4 + j] = b1[j]; } }
#pragma unroll
            for (int r = 0; r < 7; ++r) unpack8(xq[r], xr[r]);
#pragma unroll
            for (int q = 0; q < 4; ++q) { f32x4 o0, o1;
#pragma unroll
                for (int j = 0; j < 4; ++j) {
                    o0[j] = bias[j] + w[0][j] * xr[q][j] + w[1][j] * xr[q + 1][j] + w[2][j] * xr[q + 2][j] + w[3][j] * xr[q + 3][j];
                    o1[j] = bias[4 + j] + w[0][4 + j] * xr[q][4 + j] + w[1][4 + j] * xr[q + 1][4 + j] + w[2][4 + j] * xr[q + 2][4 + j] + w[3][4 + j] * xr[q + 3][4 + j]; }
                *(LAS f32x4*)(XC + (4 * tq + q) * 132 + cg8 * 8) = o0; *(LAS f32x4*)(XC + (4 * tq + q) * 132 + cg8 * 8 + 4) = o1; }
        }
        __syncthreads();
        f32x4 bval[8];
        const int cl = 16 * wid + 4 * fq;
        {
            const bf16_t* Wg = (const bf16_t*)(a.ws + OFF_WRG) + (size_t)(k2 * 8 + h) * 256 * 128;
            bf16x8 bfr[2][4];
#pragma unroll
            for (int wh = 0; wh < 2; ++wh)
#pragma unroll
                for (int ks = 0; ks < 4; ++ks) bfr[wh][ks] = *(const bf16x8*)(Wg + (size_t)(wh * 128 + 16 * wid + fr) * 128 + 32 * ks + 8 * fq);
            const int c = k2 * D + h * 128 + cl;
            const f32x4 ba = *(const f32x4*)(a.rg_b_a + c) * -1.4426950408889634f, bx = *(const f32x4*)(a.rg_b_x + c) * -1.4426950408889634f, nsp = *(const f32x4*)((const float*)(a.ws + OFF_NSP) + c);
#pragma unroll
            for (int mb = 0; mb < 8; ++mb) {
                f32x4 accR = (f32x4){0.f, 0.f, 0.f, 0.f}, accI = accR;
                {
                    const LAS float* p = XC + (16 * mb + fr) * 132 + 8 * fq; f32x4 v[8];
                    asm volatile("ds_read_b128 %0, %8\n\tds_read_b128 %1, %8 offset:16\n\tds_read_b128 %2, %8 offset:128\n\tds_read_b128 %3, %8 offset:144\n\t"
                                 "ds_read_b128 %4, %8 offset:256\n\tds_read_b128 %5, %8 offset:272\n\tds_read_b128 %6, %8 offset:384\n\tds_read_b128 %7, %8 offset:400\n\ts_waitcnt lgkmcnt(0)"
                                 : "=&v"(v[0]), "=&v"(v[1]), "=&v"(v[2]), "=&v"(v[3]), "=&v"(v[4]), "=&v"(v[5]), "=&v"(v[6]), "=&v"(v[7]) : "v"(p) : "memory");
#pragma unroll
                    for (int ks = 0; ks < 4; ++ks) { const u32x4 pk = pack8(v[2 * ks], v[2 * ks + 1]); const bf16x8 af = __builtin_bit_cast(bf16x8, pk);
                        accR = __builtin_amdgcn_mfma_f32_16x16x32_bf16(bfr[0][ks], af, accR, 0, 0, 0); accI = __builtin_amdgcn_mfma_f32_16x16x32_bf16(bfr[1][ks], af, accI, 0, 0, 0); } }
                const int t = 16 * mb + fr; const f32x4 xc = *(const LAS f32x4*)(XC + t * 132 + cl); f32x4 av;
#pragma unroll
                for (int j = 0; j < 4; ++j) {
                    const float r = __builtin_amdgcn_rcpf(1.0f + __builtin_amdgcn_exp2f(fmaf(accR[j], -1.4426950408889634f, ba[j])));
                    const float ig = __builtin_amdgcn_rcpf(1.0f + __builtin_amdgcn_exp2f(fmaf(accI[j], -1.4426950408889634f, bx[j])));
                    const float aa = __builtin_amdgcn_exp2f(nsp[j] * r); av[j] = aa; bval[mb][j] = __builtin_amdgcn_sqrtf(fmaxf(1.0f - aa * aa, 0.f)) * (ig * xc[j]); }
                *(LAS f32x4*)(SA + t * 132 + cl) = av;
            }
        }
        __syncthreads();
#pragma unroll
        for (int mb = 0; mb < 8; ++mb) *(LAS f32x4*)(XC + (16 * mb + fr) * 132 + cl) = bval[mb];
        __syncthreads();
        if (h < 7) RG_PF_CONV(h + 1);
        {
            const int c = tid & 127, sg = tid >> 7;
            float P = 1.f, Hh = 0.f;
#pragma unroll 1
            for (int ib = 0; ib < 4; ++ib) {
                float av[8], bv[8];
#pragma unroll
                for (int i = 0; i < 8; ++i) { const int t = 32 * sg + 8 * ib + i; av[i] = SA[t * 132 + c]; bv[i] = XC[t * 132 + c]; }
#pragma unroll
                for (int i = 0; i < 8; ++i) { Hh = av[i] * Hh + bv[i]; P *= av[i]; bv[i] = Hh; av[i] = P; }
#pragma unroll
                for (int i = 0; i < 8; ++i) { const int t = 32 * sg + 8 * ib + i; XC[t * 132 + c] = bv[i]; SA[t * 132 + c] = av[i]; }
            }
            SEG[(sg * 128 + c) * 2] = P; SEG[(sg * 128 + c) * 2 + 1] = Hh;
        }
        __syncthreads();
        {
            const int cg8 = tid & 15, tq = tid >> 4;
            float Ain[8], Hin[8];
#pragma unroll
            for (int j = 0; j < 8; ++j) { Ain[j] = 1.f; Hin[j] = 0.f; }
#pragma unroll
            for (int i = 0; i < 4; ++i) { const int t = tq + 32 * i; const size_t cb2 = (size_t)(h * 128 + cg8 * 8) * 2;
                const LAS float* p = XC + t * 132 + cg8 * 8; const LAS float* q = SA + t * 132 + cg8 * 8;
                const f32x4 h0 = *(const LAS f32x4*)p, h1 = *(const LAS f32x4*)(p + 4), p0 = *(const LAS f32x4*)q, p1 = *(const LAS f32x4*)(q + 4);
                f32x4 ho0, ho1, po0, po1;
#pragma unroll
                for (int j = 0; j < 4; ++j) { ho0[j] = h0[j] + p0[j] * Hin[j]; po0[j] = p0[j] * Ain[j]; ho1[j] = h1[j] + p1[j] * Hin[4 + j]; po1[j] = p1[j] * Ain[4 + j]; }
                *(u32x4*)(AB + act_off(t0 + t, 2048, (size_t)16 << 20) + cb2) = pack8(ho0, ho1);
                *(u32x4*)(AB + act_off(t0 + t, 2048, (size_t)24 << 20) + cb2) = pack8(po0, po1);
#pragma unroll
                for (int j2 = 0; j2 < 4; ++j2) { const f32x4 sv = *(const LAS f32x4*)(SEG + (i * 128 + cg8 * 8 + 2 * j2) * 2);
                    Hin[2 * j2] = sv[0] * Hin[2 * j2] + sv[1]; Ain[2 * j2] *= sv[0]; Hin[2 * j2 + 1] = sv[2] * Hin[2 * j2 + 1] + sv[3]; Ain[2 * j2 + 1] *= sv[2]; } }
            if (tq == 0) {
#pragma unroll
                for (int j = 0; j < 8; ++j) { CHA[(size_t)ch * D + h * 128 + cg8 * 8 + j] = Ain[j]; CHH[(size_t)ch * D + h * 128 + cg8 * 8 + j] = Hin[j]; } }
        }
        __syncthreads();
      }
#undef RG_PF_CONV
    }
}

__device__ __forceinline__ void rg_out_phase(const Args& a, int vb, LAS unsigned char* lds) {
    int tid_ = threadIdx.x; asm volatile("" : "+v"(tid_)); const int tid = tid_;
    LAS float* CAR = (LAS float*)lds;
    unsigned char* AB = a.ws + OFF_ACT;
    const float* CHA = (const float*)(a.ws + OFF_CHA); const float* CHH = (const float*)(a.ws + OFF_CHH);
    for (int ch = vb; ch < 256; ch += gridDim.x) {
        const int firstc = ch & ~127, t0 = ch * 128;
        {
            const int q = tid & 255, hv = tid >> 8, n = ch - firstc, nlo = n >> 1, jb = firstc + (hv ? nlo : 0), je = hv ? ch : firstc + nlo;
            f32x4 Aa = (f32x4){1.f, 1.f, 1.f, 1.f}, Hh = (f32x4){0.f, 0.f, 0.f, 0.f};
#pragma unroll 8
            for (int j = jb; j < je; ++j) { const f32x4 av = *(const f32x4*)(CHA + (size_t)j * D + 4 * q), hv4 = *(const f32x4*)(CHH + (size_t)j * D + 4 * q); Hh = av * Hh + hv4; Aa = Aa * av; }
            LAS f32x4* TMP = (LAS f32x4*)(CAR + 1024);
            if (hv) { TMP[q * 2] = Aa; TMP[q * 2 + 1] = Hh; }
            __syncthreads();
            if (!hv) { const f32x4 A2 = TMP[q * 2], H2 = TMP[q * 2 + 1]; *(LAS f32x4*)(CAR + 4 * q) = A2 * Hh + H2; }
        }
        __syncthreads();
        const int cg8 = tid & 127; const f32x4 ca = *(const LAS f32x4*)(CAR + cg8 * 8), cb = *(const LAS f32x4*)(CAR + cg8 * 8 + 4);
        const float car[8] = {ca[0], ca[1], ca[2], ca[3], cb[0], cb[1], cb[2], cb[3]};
        const size_t cb2 = (size_t)cg8 * 16;
#pragma unroll 1
        for (int ib = 0; ib < 8; ++ib) {
            u32x4 qh[4], qa[4], qg[4];
#pragma unroll
            for (int k = 0; k < 4; ++k) { const int t = (tid >> 7) + 4 * (4 * ib + k);
                qh[k] = *(const u32x4*)(AB + act_off(t0 + t, 2048, (size_t)16 << 20) + cb2); qa[k] = *(const u32x4*)(AB + act_off(t0 + t, 2048, (size_t)24 << 20) + cb2);
                qg[k] = *(const u32x4*)(AB + act_off(t0 + t, 2048, (size_t)8 << 20) + cb2); }
#pragma unroll
            for (int k = 0; k < 4; ++k) { const int t = (tid >> 7) + 4 * (4 * ib + k);
                float hl[8], ap[8], gb[8]; unpack8(qh[k], hl); unpack8(qa[k], ap); unpack8(qg[k], gb);
                f32x4 y0, y1;
#pragma unroll
                for (int j = 0; j < 4; ++j) { y0[j] = (hl[j] + ap[j] * car[j]) * gelu_t(gb[j]); y1[j] = (hl[4 + j] + ap[4 + j] * car[4 + j]) * gelu_t(gb[4 + j]); }
                *(u32x4*)(AB + act_off(t0 + t, 2048, (size_t)8 << 20) + cb2) = pack8(y0, y1); }
        }
        __syncthreads();
    }
}

__device__ __forceinline__ void gm_gate_phase(const Args& a, int vb, int k2, LAS unsigned char* lds) {
    int tid_ = threadIdx.x; asm volatile("" : "+v"(tid_)); const int tid = tid_, wid = tid >> 6, lane = tid & 63, fr = lane & 15, fq = lane >> 4;
    constexpr int VS = 272, AS = 136;
    LAS bf16_t* VT = (LAS bf16_t*)lds;
    LAS bf16_t* AW = VT + 128 * VS;
    LAS float* MU = (LAS float*)(AW + 128 * AS); LAS float* RSTD = MU + 128; LAS float* C1 = RSTD + 128; LAS float* C2S = C1 + 128; LAS float* BSS = C2S + 128;
    unsigned char* AB = a.ws + OFF_ACT;
    const float* VSTAT = (const float*)(a.ws + OFF_VSTAT); const float* C2 = (const float*)(a.ws + OFF_C2);
    const bf16_t* WGS = (const bf16_t*)(a.ws + OFF_WGS);
    for (int ch = vb; ch < 256; ch += gridDim.x) {
        const int t0 = ch * 128;
        u32x4 vq[8], wq4[4];
        { const bf16_t* wp0 = WGS + ((size_t)(k2 * 8 + 0) * 128 + (tid >> 2)) * 128 + 32 * (tid & 3);
#pragma unroll
          for (int p = 0; p < 4; ++p) wq4[p] = *(const u32x4*)(wp0 + 8 * p); }
#pragma unroll
        for (int i = 0; i < 8; ++i) { const int item = tid + 512 * i, row = item >> 5, c16 = item & 31; vq[i] = *(const u32x4*)(AB + act_off(t0 + row, 4096, (size_t)16 << 20) + (size_t)c16 * 16); }
        if (tid < 128) { const float* p = VSTAT + (size_t)(t0 + tid) * 64; float s = 0.f, q = 0.f;
#pragma unroll
            for (int i = 0; i < 16; ++i) { const f32x4 v = *(const f32x4*)(p + 4 * i); s += v[0] + v[2]; q += v[1] + v[3]; }
            const float mu = s * (1.0f / 2048.0f), var = fmaxf(q * (1.0f / 2048.0f) - mu * mu, 0.f); MU[tid] = mu; RSTD[tid] = rsqrtf(var + EPS); }
        __syncthreads();
        for (int g = 0; g < 8; ++g) {
            const int d0 = g * 256 + 32 * wid + 8 * fq;
            u32x4 uq[8];
#pragma unroll
            for (int mb = 0; mb < 8; ++mb)
                uq[mb] = *(const u32x4*)(AB + act_off(t0 + 16 * mb + fr, 4096, 0) + (size_t)d0 * 2);
            f32x4 gd[2], bd[2];
#pragma unroll
            for (int nb = 0; nb < 2; ++nb) { gd[nb] = *(const f32x4*)(a.gm_ln_g + (size_t)k2 * 2048 + d0 + 4 * nb); bd[nb] = *(const f32x4*)(a.gm_ln_b + (size_t)k2 * 2048 + d0 + 4 * nb); }
            {
                const int t = tid >> 2, sq = tid & 3; float c1 = 0.f;
                if (tid < 128) { C2S[tid] = C2[(k2 * 8 + g) * 128 + tid]; BSS[tid] = a.gm_b_s[(size_t)(k2 * 8 + g) * 128 + tid]; }
#pragma unroll
                for (int p = 0; p < 4; ++p) { float f[8]; unpack8(wq4[p], f); f32x4 f0, f1;
#pragma unroll
                    for (int j = 0; j < 4; ++j) { f0[j] = f[j] * RSTD[32 * sq + 8 * p + j]; f1[j] = f[4 + j] * RSTD[32 * sq + 8 * p + 4 + j]; }
                    const u32x4 pk = pack8(f0, f1); float fr8[8]; unpack8(pk, fr8);
#pragma unroll
                    for (int j = 0; j < 8; ++j) c1 += fr8[j] * MU[32 * sq + 8 * p + j];
                    *(LAS u32x4*)(AW + t * AS + 32 * sq + 8 * p) = pk; }
                c1 += __shfl_xor(c1, 1); c1 += __shfl_xor(c1, 2);
                if (sq == 0) C1[t] = c1;
            }
            {
#pragma unroll
                for (int i = 0; i < 8; ++i) { const int item = tid + 512 * i, row = item >> 5, c16 = item & 31; const u32x4 q = vq[i];
                    LAS u32x2* dp = (LAS u32x2*)(VT + row * VS + 8 * c16); dp[0] = (u32x2){q.x, q.y}; dp[1] = (u32x2){q.z, q.w}; }
            }
            __syncthreads();
            if (g < 7) {
                { const bf16_t* wpn = WGS + ((size_t)(k2 * 8 + g + 1) * 128 + (tid >> 2)) * 128 + 32 * (tid & 3);
#pragma unroll
                  for (int p = 0; p < 4; ++p) wq4[p] = *(const u32x4*)(wpn + 8 * p); }
#pragma unroll
                for (int i = 0; i < 8; ++i) { const int item = tid + 512 * i, row = item >> 5, c16 = item & 31; vq[i] = *(const u32x4*)(AB + act_off(t0 + row, 4096, (size_t)16 << 20) + (size_t)((g + 1) * 256 + 8 * c16) * 2); } }
#pragma unroll 1
            for (int hf = 0; hf < 2; ++hf) {
                float c2t[4], bst[4];
#pragma unroll
                for (int ml = 0; ml < 4; ++ml) { const int t = 64 * hf + 16 * ml + fr;
                    c2t[ml] = C2S[t]; bst[ml] = BSS[t];
                }
                f32x4 acc[4][2];
#pragma unroll
                for (int ml = 0; ml < 4; ++ml) { acc[ml][0] = (f32x4){0.f, 0.f, 0.f, 0.f}; acc[ml][1] = acc[ml][0]; }
#pragma unroll 1
                for (int ks = 0; ks < 2 * hf + 2; ++ks) {
                    bf16x8 vf[2];
                    {
                        const LAS bf16_t* vp = VT + (32 * ks + 8 * fq + ((lane & 15) >> 2)) * VS + 32 * wid + 8 * (lane & 3);
                        u32x2 r00, r01, r10, r11;
                        asm volatile("ds_read_b64_tr_b16 %0, %4\n\tds_read_b64_tr_b16 %1, %4 offset:2176\n\tds_read_b64_tr_b16 %2, %4 offset:8\n\tds_read_b64_tr_b16 %3, %4 offset:2184\n\ts_waitcnt lgkmcnt(0)"
                                     : "=&v"(r00), "=&v"(r01), "=&v"(r10), "=&v"(r11) : "v"(vp) : "memory");
                        vf[0] = __builtin_bit_cast(bf16x8, (u32x4){r00.x, r00.y, r01.x, r01.y});
                        vf[1] = __builtin_bit_cast(bf16x8, (u32x4){r10.x, r10.y, r11.x, r11.y}); }
                    bf16x8 af4[4];
                    {   const LAS bf16_t* ap = AW + (64 * hf + fr) * AS + 32 * ks + 8 * fq;
                        asm volatile("ds_read_b128 %0, %4\n\tds_read_b128 %1, %4 offset:4352\n\tds_read_b128 %2, %4 offset:8704\n\tds_read_b128 %3, %4 offset:13056\n\ts_waitcnt lgkmcnt(0)"
                                     : "=&v"(af4[0]), "=&v"(af4[1]), "=&v"(af4[2]), "=&v"(af4[3]) : "v"(ap) : "memory"); }
#pragma unroll
                    for (int ml = 0; ml < 4; ++ml) if (64 * hf + 16 * ml + 15 >= 32 * ks) {
                        acc[ml][0] = __builtin_amdgcn_mfma_f32_16x16x32_bf16(vf[0], af4[ml], acc[ml][0], 0, 0, 0);
                        acc[ml][1] = __builtin_amdgcn_mfma_f32_16x16x32_bf16(vf[1], af4[ml], acc[ml][1], 0, 0, 0); }
                }
#pragma unroll
                for (int ml = 0; ml < 4; ++ml) { const int t = 64 * hf + 16 * ml + fr; const float c1t = C1[t];
                    const u32x4 uw = hf ? uq[4 + ml] : uq[ml];
                    const f32x4 u0 = (f32x4){bf_lo(uw.x), bf_hi(uw.x), bf_lo(uw.y), bf_hi(uw.y)}, u1 = (f32x4){bf_lo(uw.z), bf_hi(uw.z), bf_lo(uw.w), bf_hi(uw.w)};
                    const f32x4 y0 = u0 * (gd[0] * (acc[ml][0] - c1t) + bd[0] * c2t[ml] + bst[ml]), y1 = u1 * (gd[1] * (acc[ml][1] - c1t) + bd[1] * c2t[ml] + bst[ml]);
                    *(u32x4*)(AB + act_off(t0 + t, 4096, 0) + (size_t)d0 * 2) = pack8(y0, y1); }
            }
            __syncthreads();
        }
    }
}

template <class Epi> __device__ __forceinline__ void run_gemm(LAS unsigned char* lds, int c, const bf16_t* A, size_t ars, const bf16_t* Bt, int N, int K, const Epi& E) {
    StaticOrder S; S.init(T, N, (int)gridDim.x, c);
    Gemm g; g.A = A; g.Bt = Bt; g.M = T; g.N = N; g.K = K; g.ars = ars;
    gemm_phase<Epi, StaticOrder, false>(lds, g, S, E, nullptr);
}

__global__ void __launch_bounds__(512) fwd_megakernel(Args a) {
    extern __shared__ __attribute__((aligned(16))) unsigned char shm[];
    LAS unsigned char* lds = (LAS unsigned char*)shm;
    cg::grid_group grid = cg::this_grid();
#ifdef TPROBE
    const unsigned long long tkstart = __builtin_amdgcn_s_memrealtime();
#endif
    volatile LAS unsigned* xst = (volatile LAS unsigned*)(lds + LDS_BYTES - 16);
    unsigned* LOC = (unsigned*)(a.ws + OFF_LOC);
    const unsigned myx = xb_xcc_id() & 7u;
    if (threadIdx.x == 0) { xst[0] = 0u; xst[1] = 0u; xst[2] = xb_add(LOC + 64 * myx, 1u); }
    __syncthreads();
    const XcdBarrier xb = xcd_barrier_post((unsigned*)(a.ws + OFF_BAR), xst);
    const unsigned myr = xst[2];
    bf16_t* H = (bf16_t*)(a.ws + OFF_H); bf16_t* O = (bf16_t*)(a.ws + OFF_O); bf16_t* ACT = (bf16_t*)(a.ws + OFF_ACT);
    float* SSQ = (float*)(a.ws + OFF_SSQ);

    prep_phase(a, lds);
    if (a.ws == nullptr) grid.sync();
    xcd_barrier(xb);
#ifdef FORCE_FALLBACK
    bool okl = false;
#else
    bool okl = (gridDim.x == 256);
#endif
#pragma unroll
    for (int x = 0; x < 8; ++x) okl = okl && (xb_ld(LOC + 64 * x) == 32u);
    const int vb = okl ? (int)(myx * 32u + myr) : (int)blockIdx.x;
    const int cg_ = okl ? (int)(myr * 8u + myx) : (int)blockIdx.x;
    unsigned* lcnt = LOC + 64 * (8 + myx);
#ifdef TPROBE
    unsigned long long tacc = 0ull, tprev = __builtin_amdgcn_s_memrealtime(); int tcur = 1; if (TPROBE == 3) tacc = tprev - tkstart;
#define TCAT(c) tcur = (c)
#define TSTAMP() do { const unsigned long long t_ = __builtin_amdgcn_s_memrealtime(); if (tcur == TPROBE) tacc += t_ - tprev; tprev = t_; } while (0)
#define GSYNC() do { xcd_barrier(xb); TSTAMP(); } while (0)
#else
#define TCAT(c)
#define TSTAMP()
#define GSYNC() xcd_barrier(xb)
#endif
#define LSYNC() do { if (okl) xcc_local_barrier(lcnt, 32u); else xcd_barrier(xb); TSTAMP(); } while (0)
    const size_t ARS_H = (size_t)4096 * D * 2;

    TCAT(1); ew_phase(a, vb, -1, 0, 0, a.x, a.out, H);
    LSYNC();
    for (int si = 0; si < 12; ++si) {
        const int l = si / 3, j = si % 3, k2 = l >> 1;
        const int type = (j != 1) ? 0 : ((l & 1) ? 2 : 1);
        const bf16_t* A2; const bf16_t* B2; int K2;
        if (type == 0) {
            const int fi = l * 2 + (j >> 1);
            EpiSwiglu e; e.O = ACT; TCAT(0);
            run_gemm(lds, cg_, H, ARS_H, (const bf16_t*)(a.ws + OFF_WFI) + (size_t)fi * 5632 * 1024, 5632, 1024, e);
            A2 = ACT; B2 = (const bf16_t*)(a.ws + OFF_WFO) + (size_t)fi * 1024 * 2816; K2 = 2816;
            LSYNC();
        } else if (type == 1) {
            TCAT(0); EpiSplit<0> e; e.O0 = ACT; e.O1 = nullptr; e.half = 1024; e.vstat = nullptr;
            run_gemm(lds, cg_, H, ARS_H, (const bf16_t*)(a.ws + OFF_WRI) + (size_t)k2 * 2048 * 1024, 2048, 1024, e);
            GSYNC();
            TCAT(2); rg_scan_phase(a, vb, k2, lds);
            GSYNC();
#ifdef SKEW_ITERS
            if (okl && myx >= 4u) { for (int i_ = 0; i_ < SKEW_ITERS; ++i_) __builtin_amdgcn_s_sleep(127); }
#endif
            TCAT(5); rg_out_phase(a, vb, lds);
            A2 = (const bf16_t*)((const unsigned char*)ACT + ((size_t)8 << 20)); B2 = (const bf16_t*)(a.ws + OFF_WRO) + (size_t)k2 * 1024 * 1024; K2 = 1024;
            LSYNC();
        } else {
            TCAT(0); EpiSplit<1> e; e.O0 = ACT; e.O1 = nullptr; e.half = 2048; e.vstat = (float*)(a.ws + OFF_VSTAT);
            run_gemm(lds, cg_, H, ARS_H, (const bf16_t*)(a.ws + OFF_WGI) + (size_t)k2 * 4096 * 1024, 4096, 1024, e);
            LSYNC();
            TCAT(6); gm_gate_phase(a, vb, k2, lds);
            A2 = ACT; B2 = (const bf16_t*)(a.ws + OFF_WGO) + (size_t)k2 * 1024 * 2048; K2 = 2048;
            LSYNC();
        }
        TCAT(0);
        { EpiOutSsq e; e.O = (si & 1) ? (bf16_t*)(a.ws + OFF_O2) : O; e.ssq = (si & 1) ? (float*)(a.ws + OFF_SSQ2) : SSQ; run_gemm(lds, cg_, A2, REGB, B2, 1024, K2, e); }
        LSYNC();
        TCAT(1); ew_phase(a, vb, si, si < 11 ? si + 1 : -1, (si & 1) ? 2 : 1, si <= 1 ? a.x : a.out, a.out, H);
        LSYNC();
    }
#ifdef TPROBE
    {
        float* TM = (float*)(a.ws + OFF_C2);
        if (vb == 0 && threadIdx.x == 0) TM[0] = (float)tacc * 0.01f * TSCALE;
        xcd_barrier(xb);
        const float eps_ = TM[0];
        for (int r = 0; r < 128; ++r) { float* p = a.out + (size_t)(vb * 128 + r) * D; for (int c_ = threadIdx.x; c_ < D; c_ += 512) p[c_] *= (1.0f + eps_); }
    }
#endif
}

extern "C" void kernel_launch(void* const* d_in, const int* in_sizes, int n_in, void* d_out, int out_size, void* d_ws, size_t ws_size, hipStream_t stream) {
    static int grid_blocks = 0;
    if (grid_blocks == 0) {
        if (n_in != 23 || out_size != T * D || ws_size < WS_END) { fprintf(stderr, "kernel_launch: unexpected shapes (n_in %d out %d ws %zu need %zu)\n", n_in, out_size, ws_size, (size_t)WS_END); grid_blocks = -1; return; }
        int dev = 0, cus = 0, per_cu = 0;
        hipGetDevice(&dev);
        hipDeviceGetAttribute(&cus, hipDeviceAttributeMultiprocessorCount, dev);
        if (hipFuncSetAttribute((const void*)fwd_megakernel, hipFuncAttributeMaxDynamicSharedMemorySize, LDS_BYTES) != hipSuccess) { fprintf(stderr, "kernel_launch: hipFuncSetAttribute failed\n"); (void)hipGetLastError(); }
        if (hipOccupancyMaxActiveBlocksPerMultiprocessor(&per_cu, (const void*)fwd_megakernel, 512, LDS_BYTES) != hipSuccess || per_cu < 1) { fprintf(stderr, "kernel_launch: occupancy query gave %d\n", per_cu); (void)hipGetLastError(); per_cu = 1; }
        grid_blocks = cus * 1;
        if (grid_blocks <= 0) grid_blocks = 256;
    }
    if (grid_blocks < 0) return;
    Args a{};
    const float** ap = (const float**)&a;
    for (int i = 0; i < 23; ++i) ap[i] = (const float*)d_in[i];
    a.out = (float*)d_out; a.ws = (unsigned char*)d_ws;
    if (hipMemsetAsync((unsigned char*)d_ws + OFF_BAR, 0, WS_END - OFF_BAR, stream) != hipSuccess) { fprintf(stderr, "kernel_launch: memset failed\n"); return; }
    void* args[] = {&a};
    hipError_t e = hipLaunchCooperativeKernel((const void*)fwd_megakernel, dim3(grid_blocks), dim3(512), args, LDS_BYTES, stream);
    if (e != hipSuccess) fprintf(stderr, "cooperative launch failed: %s (grid %d)\n", hipGetErrorString(e), grid_blocks);
}
```
